# Optimizing an MI355X kernel written in HIP

```python
import math
import jax, jax.numpy as jnp
from jax import lax
import numpy as np

D_MODEL = 1024
BATCH = 8
SEQ = 4096
DEPTH = 1

EPS = 1e-6
MIX_WIDTH = D_MODEL
RET_DIM = 64
RET_WIDTH = MIX_WIDTH // 2
RET_HEADS = RET_WIDTH // RET_DIM
DIFF_DIM = 64
DIFF_WIDTH = MIX_WIDTH - RET_WIDTH
DIFF_HEADS = DIFF_WIDTH // (2 * DIFF_DIM)
IN_WIDTH = 4 * RET_WIDTH + 3 * DIFF_WIDTH
D_FF = 2816
N_BUCKETS = 32
MAX_DIST = 128
CHUNK = 128
Q_BLOCK = 128
ROPE_BASE = 10000.0
N_MOD = 9
NEG_INF = -1e30

kernel_name = "hybrid_retention_diffattn_macaron_adaln"


def rmsnorm(x, g):
    xf = x.astype(jnp.float32)
    y = xf * lax.rsqrt(jnp.mean(xf * xf, axis=-1, keepdims=True) + EPS)
    return (y * g.astype(jnp.float32)).astype(x.dtype)


def head_layernorm(x):
    xf = x.astype(jnp.float32)
    mu = jnp.mean(xf, axis=-1, keepdims=True)
    var = jnp.mean(jnp.square(xf - mu), axis=-1, keepdims=True)
    return ((xf - mu) * lax.rsqrt(var + EPS)).astype(x.dtype)


def modulate(h, shift, scale):
    return h * (1.0 + scale[:, None, :]) + shift[:, None, :]


def swiglu(h, w_in, w_down):
    g, u = jnp.split(h @ w_in, 2, axis=-1)
    return (jax.nn.silu(g) * u) @ w_down


def rope(x, pos):
    d = x.shape[-1]
    inv = ROPE_BASE ** (-jnp.arange(0, d, 2, dtype=jnp.float32) / d)
    ang = pos.astype(jnp.float32)[:, None] * inv[None, :]
    cos = jnp.cos(ang).astype(x.dtype)
    sin = jnp.sin(ang).astype(x.dtype)
    x1, x2 = x[..., : d // 2], x[..., d // 2:]
    return jnp.concatenate([x1 * cos - x2 * sin, x1 * sin + x2 * cos], axis=-1)


def t5_bucket(rel):
    n = jnp.maximum(rel, 0)
    max_exact = N_BUCKETS // 2
    nf = jnp.maximum(n, 1).astype(jnp.float32)
    large = max_exact + (jnp.log(nf / max_exact) / math.log(MAX_DIST / max_exact)
                         * (N_BUCKETS - max_exact)).astype(jnp.int32)
    large = jnp.minimum(large, N_BUCKETS - 1)
    return jnp.where(n < max_exact, n, large)


def retention(q, k, v):
    B, H, S, d = q.shape
    NC = S // CHUNK
    dt = q.dtype
    log_gamma = jnp.log1p(-(2.0 ** (-5.0 - jnp.arange(H, dtype=jnp.float32))))
    qc = q.reshape(B, H, NC, CHUNK, d)
    kc = k.reshape(B, H, NC, CHUNK, d)
    vc = v.reshape(B, H, NC, CHUNK, d)
    idx = jnp.arange(CHUNK, dtype=jnp.float32)
    dist = idx[:, None] - idx[None, :]
    decay_in = jnp.where(dist >= 0,
                         jnp.exp(log_gamma[:, None, None] * jnp.maximum(dist, 0.0)[None]),
                         0.0).astype(dt)
    s = jnp.einsum('bhncd,bhnkd->bhnck', qc, kc) * decay_in[None, :, None]
    intra = jnp.einsum('bhnck,bhnkd->bhncd', s, vc)
    zeta = jnp.exp(log_gamma[:, None] * (CHUNK - 1 - idx)[None]).astype(dt)
    kv = jnp.einsum('bhnkd,bhnke->bhnde', kc * zeta[None, :, None, :, None], vc)
    gamma_c = jnp.exp(log_gamma * CHUNK).astype(kv.dtype)[None, :, None, None]

    def step(R, kv_n):
        return R * gamma_c + kv_n, R

    R0 = jnp.zeros((B, H, d, d), dtype=kv.dtype)
    _, R_prev = lax.scan(step, R0, jnp.moveaxis(kv, 2, 0))
    R_prev = jnp.moveaxis(R_prev, 0, 2)
    xi = jnp.exp(log_gamma[:, None] * (idx + 1.0)[None]).astype(dt)
    cross = jnp.einsum('bhncd,bhnde->bhnce', qc, R_prev) * xi[None, :, None, :, None]
    return (intra + cross).reshape(B, H, S, d)


def diff_attention(q, k, v, lam, rel_bias):
    B, H, _, S, d = q.shape
    NB = S // Q_BLOCK
    scale = d ** -0.5
    kpos = jnp.arange(S)
    qb = q.reshape(B, H, 2, NB, Q_BLOCK, d)

    def block(i):
        qi = lax.dynamic_index_in_dim(qb, i, axis=3, keepdims=False)
        qpos = i * Q_BLOCK + jnp.arange(Q_BLOCK)
        rel = qpos[:, None] - kpos[None, :]
        bias = jnp.transpose(rel_bias[t5_bucket(rel)], (2, 0, 1)).astype(jnp.float32)
        logits = jnp.einsum('bhmqd,bhmkd->bhmqk', qi, k).astype(jnp.float32) * scale
        logits = logits + bias[None, :, None]
        logits = jnp.where(rel[None, None, None] >= 0, logits, NEG_INF)
        p = jax.nn.softmax(logits, axis=-1)
        a = p[:, :, 0] - lam * p[:, :, 1]
        return jnp.einsum('bhqk,bhke->bhqe', a.astype(v.dtype), v)

    out = lax.map(block, jnp.arange(NB))
    return jnp.moveaxis(out, 0, 2).reshape(B, H, S, 2 * d)


def token_mixer(h, w_in_l, lam, lambda_init, subln_g, grp_scale, w_out_l, rel_bias):
    B, S, _ = h.shape
    proj = h @ w_in_l
    splits = np.cumsum([RET_WIDTH] * 4 + [DIFF_WIDTH] * 2).tolist()
    rq, rk, rv, rg, dq, dk, dv = jnp.split(proj, splits, axis=-1)
    pos = jnp.arange(S)

    to_heads = lambda t: t.reshape(B, S, RET_HEADS, RET_DIM).transpose(0, 2, 1, 3)
    rq = rope(to_heads(rq), pos)
    rk = rope(to_heads(rk), pos) * (RET_DIM ** -0.5)
    y_ret = head_layernorm(retention(rq, rk, to_heads(rv)))
    y_ret = y_ret.transpose(0, 2, 1, 3).reshape(B, S, RET_WIDTH) * jax.nn.silu(rg)

    dq = dq.reshape(B, S, DIFF_HEADS, 2, DIFF_DIM).transpose(0, 2, 3, 1, 4)
    dk = dk.reshape(B, S, DIFF_HEADS, 2, DIFF_DIM).transpose(0, 2, 3, 1, 4)
    dv = dv.reshape(B, S, DIFF_HEADS, 2 * DIFF_DIM).transpose(0, 2, 1, 3)
    y_diff = rmsnorm(diff_attention(dq, dk, dv, lam, rel_bias), subln_g) * (1.0 - lambda_init)
    y_diff = y_diff.transpose(0, 2, 1, 3).reshape(B, S, DIFF_WIDTH)

    y = jnp.concatenate([y_ret, y_diff], axis=-1) * grp_scale
    return y @ w_out_l


def setup_inputs(seed: int = 0) -> dict:
    key = jax.random.key(seed)
    ks = jax.random.split(key, 24)
    nrm = lambda k, shape, s: jax.random.normal(k, shape, jnp.float32) * s
    gain = lambda k, shape: 1.0 + 0.05 * jax.random.normal(k, shape, jnp.float32)
    L, D = DEPTH, D_MODEL
    return {
        "x": nrm(ks[0], (BATCH, SEQ, D), 1.0),
        "c": nrm(ks[1], (BATCH, D), 1.0),
        "w_ada": nrm(ks[2], (L, D, N_MOD * D), 0.5 * D ** -0.5),
        "b_ada": nrm(ks[3], (L, N_MOD * D), 0.01),
        "norm_ffn1": gain(ks[4], (L, D)),
        "w_ffn1_in": nrm(ks[5], (L, D, 2 * D_FF), D ** -0.5),
        "w_ffn1_out": nrm(ks[6], (L, D_FF, D), D_FF ** -0.5),
        "norm_mix": gain(ks[7], (L, D)),
        "w_in": nrm(ks[8], (L, D, IN_WIDTH), D ** -0.5),
        "lambda_q1": nrm(ks[9], (L, DIFF_DIM), 0.1),
        "lambda_k1": nrm(ks[10], (L, DIFF_DIM), 0.1),
        "lambda_q2": nrm(ks[11], (L, DIFF_DIM), 0.1),
        "lambda_k2": nrm(ks[12], (L, DIFF_DIM), 0.1),
        "subln_gain": gain(ks[13], (L, 2 * DIFF_DIM)),
        "group_scale": gain(ks[14], (L, MIX_WIDTH)),
        "w_out": nrm(ks[15], (L, MIX_WIDTH, D), MIX_WIDTH ** -0.5),
        "norm_ffn2": gain(ks[16], (L, D)),
        "w_ffn2_in": nrm(ks[17], (L, D, 2 * D_FF), D ** -0.5),
        "w_ffn2_out": nrm(ks[18], (L, D_FF, D), D_FF ** -0.5),
        "rel_bias": nrm(ks[19], (N_BUCKETS, DIFF_HEADS), 0.5),
        "norm_final": gain(ks[20], (D,)),
    }


def reference(x, c, w_ada, b_ada, norm_ffn1, w_ffn1_in, w_ffn1_out, norm_mix, w_in,
              lambda_q1, lambda_k1, lambda_q2, lambda_k2, subln_gain, group_scale, w_out,
              norm_ffn2, w_ffn2_in, w_ffn2_out, rel_bias, norm_final):
    B = x.shape[0]
    for l in range(DEPTH):
        mod = (jax.nn.silu(c) @ w_ada[l] + b_ada[l]).reshape(B, N_MOD, D_MODEL)
        sh1, sc1, gt1 = mod[:, 0], mod[:, 1], mod[:, 2]
        shm, scm, gtm = mod[:, 3], mod[:, 4], mod[:, 5]
        sh2, sc2, gt2 = mod[:, 6], mod[:, 7], mod[:, 8]

        h = modulate(rmsnorm(x, norm_ffn1[l]), sh1, sc1)
        x = x + 0.5 * gt1[:, None, :] * swiglu(h, w_ffn1_in[l], w_ffn1_out[l])

        lambda_init = 0.8 - 0.6 * math.exp(-0.3 * l)
        lq1 = lambda_q1[l].astype(jnp.float32); lk1 = lambda_k1[l].astype(jnp.float32)
        lq2 = lambda_q2[l].astype(jnp.float32); lk2 = lambda_k2[l].astype(jnp.float32)
        lam = jnp.exp(jnp.sum(lq1 * lk1)) - jnp.exp(jnp.sum(lq2 * lk2)) + lambda_init
        h = modulate(rmsnorm(x, norm_mix[l]), shm, scm)
        x = x + gtm[:, None, :] * token_mixer(h, w_in[l], lam, lambda_init, subln_gain[l],
                                              group_scale[l], w_out[l], rel_bias)

        h = modulate(rmsnorm(x, norm_ffn2[l]), sh2, sc2)
        x = x + 0.5 * gt2[:, None, :] * swiglu(h, w_ffn2_in[l], w_ffn2_out[l])
    return rmsnorm(x, norm_final)
```

```cpp
#include <hip/hip_runtime.h>
#include <hip/hip_cooperative_groups.h>
#include <cstdio>
#include <cstdint>
namespace cg = cooperative_groups;

constexpr int BATCH = 8, SEQ = 4096, DM = 1024, T = BATCH * SEQ, FF = 2816, NIN = 3584, NMODC = 9 * DM;
constexpr float EPS = 1e-6f;
constexpr float LOG2E = 1.4426950408889634f;
constexpr float C2 = 0.125f * LOG2E;
namespace pg8 {
#define PG8_LAS __attribute__((address_space(3)))
typedef unsigned short bf16_t;
typedef short bf16x8 __attribute__((ext_vector_type(8)));
typedef float f32x4 __attribute__((ext_vector_type(4)));
typedef unsigned u32x4 __attribute__((ext_vector_type(4)));
constexpr int BM = 256, BK = 64, HALF = 128, HTB = HALF * BK * 2  , STAGE_BYTES = 8 * HTB, NXCD = 8, WGM = 8;

__host__ __device__ __forceinline__ int lds_byte(int r, int c) { const int st = (r >> 4) * 2 + (c >> 5), rr = r & 15, cc = c & 31, ob = rr * 64 + cc * 2; return st * 1024 + (ob ^ (((ob >> 9) & 1) << 5)); }
__host__ __device__ __forceinline__ void stage_rc(int b, int& R, int& C) { const int st = b / 1024, sb = b % 1024, swz = sb ^ (((sb >> 9) & 1) << 5); R = (st >> 1) * 16 + swz / 64; C = (st & 1) * 32 + (swz % 64) / 2; }
__host__ __device__ __forceinline__ int perm32(int rho) { const int n = rho >> 4, i = rho & 15; return 8 * (i >> 2) + 4 * n + (i & 3); }

struct Unit { int pm, pn; };
struct Gemm { const bf16_t* A; const bf16_t* Bt; int M, N, K; };

struct StaticOrder {
    int nM, nN, nwg, G, c;
    __host__ __device__ void init(int M, int N, int G_, int c_) { nM = M / BM; nN = N / BM; nwg = nM * nN; G = G_; c = c_; }
    __host__ __device__ bool next(int i, Unit& u) const {
        const long L = (long)i * G + c; if (L >= nwg) return false;
        int wgid = (int)L; { const int q = nwg / NXCD, r = nwg % NXCD, xcd = wgid % NXCD, off = wgid / NXCD; wgid = (xcd < r ? xcd * (q + 1) : r * (q + 1) + (xcd - r) * q) + off; }
        const int nig = WGM * nN, gid = wgid / nig, fm = gid * WGM, gsz = (nM - fm) < WGM ? (nM - fm) : WGM;
        u.pm = fm + ((wgid % nig) % gsz); u.pn = (wgid % nig) / gsz; return true;
    }
    __device__ __forceinline__ void a_ready(const Unit&) const {}
    __device__ __forceinline__ void done(const Unit&) const {}
};
__device__ __forceinline__ unsigned cvt_pk_bf16(float lo, float hi) { unsigned r; asm volatile("v_cvt_pk_bf16_f32 %0, %1, %2" : "=v"(r) : "v"(lo), "v"(hi)); return r; }
typedef float f32x2 __attribute__((ext_vector_type(2)));
__device__ __forceinline__ float fast_silu(float v) { return v * __builtin_amdgcn_rcpf(1.0f + __builtin_amdgcn_exp2f(-1.4426950408889634f * v)); }
template <bool DEFER> struct EpiSwiglu {
    static constexpr bool PERM = true, AFTER_DRAIN = false;
    bf16_t* O; int ldc; const float* ss; const float* bias;
    __device__ __forceinline__ void operator()(const f32x4 (&acc)[2][2][4][2], const Unit& u, int wr, int wc, int fr, int fq) const {
        const int row0 = u.pm * BM + wr * 64 + fr, col0 = u.pn * HALF + wc * 32 + 8 * fq;
        f32x4 bg0, bg1, bu0, bu1;
        if (DEFER) { const float* bp = bias + (size_t)(u.pm >> 4) * 5632 + u.pn * BM + wc * 32 + 8 * fq;
            bg0 = *(const f32x4*)bp; bg1 = *(const f32x4*)(bp + 4); bu0 = *(const f32x4*)(bp + HALF); bu1 = *(const f32x4*)(bp + HALF + 4); }
#pragma unroll
        for (int ai = 0; ai < 2; ++ai)
#pragma unroll
            for (int m = 0; m < 4; ++m) {
                bf16_t* rowp = O + (size_t)(row0 + ai * HALF + m * 16) * ldc + col0;
                f32x4 g0 = acc[ai][0][m][0], g1 = acc[ai][0][m][1], u0 = acc[ai][1][m][0], u1 = acc[ai][1][m][1];
                if (DEFER) { const float ri = __builtin_amdgcn_rsqf(ss[row0 + ai * HALF + m * 16] * (1.0f / 1024.0f) + 1e-6f);
                    g0 = g0 * ri + bg0; g1 = g1 * ri + bg1; u0 = u0 * ri + bu0; u1 = u1 * ri + bu1; }
                f32x4 v0, v1;
#pragma unroll
                for (int e = 0; e < 4; ++e) { v0[e] = fast_silu(g0[e]) * u0[e]; v1[e] = fast_silu(g1[e]) * u1[e]; }
                u32x4 w; w.x = cvt_pk_bf16(v0[0], v0[1]); w.y = cvt_pk_bf16(v0[2], v0[3]); w.z = cvt_pk_bf16(v1[0], v1[1]); w.w = cvt_pk_bf16(v1[2], v1[3]);
                *(u32x4*)rowp = w;
            }
    }
};
template <bool NEXT> struct EpiResid {
    static constexpr bool PERM = false, AFTER_DRAIN = false;
    const float* base; float* out; const float* gate; const float* ng; const float* nsc; bf16_t* hn; float* ssq; float scale;
    __device__ __forceinline__ void operator()(const f32x4 (&acc)[2][2][4][2], const Unit& u, int wr, int wc, int fr, int fq) const {
        const int col0 = u.pn * BM + wc * 32 + 4 * fq, b = u.pm >> 4;
        f32x4 gv[2][2], ab[2][2];
#pragma unroll
        for (int bj = 0; bj < 2; ++bj)
#pragma unroll
            for (int n = 0; n < 2; ++n) { gv[bj][n] = *(const f32x4*)(gate + (size_t)b * 9216 + col0 + bj * HALF + n * 16) * scale;
                if (NEXT) ab[bj][n] = *(const f32x4*)(ng + col0 + bj * HALF + n * 16) * (*(const f32x4*)(nsc + (size_t)b * 9216 + col0 + bj * HALF + n * 16) + 1.0f); }
#pragma unroll
        for (int ai = 0; ai < 2; ++ai)
#pragma unroll
            for (int m = 0; m < 4; ++m) {
                const int row = u.pm * BM + ai * HALF + wr * 64 + m * 16 + fr;
                const size_t off = (size_t)row * 1024 + col0; float sq = 0.f;
#pragma unroll
                for (int bj = 0; bj < 2; ++bj)
#pragma unroll
                    for (int n = 0; n < 2; ++n) { const f32x4 bs = *(const f32x4*)(base + off + bj * HALF + n * 16); const f32x4 o = bs + gv[bj][n] * acc[ai][bj][m][n]; *(f32x4*)(out + off + bj * HALF + n * 16) = o;
                        if (NEXT) { sq += (o[0] * o[0] + o[1] * o[1]) + (o[2] * o[2] + o[3] * o[3]); const f32x4 a = o * ab[bj][n];
                            typedef unsigned u32x2_t __attribute__((ext_vector_type(2))); u32x2_t w; w.x = cvt_pk_bf16(a[0], a[1]); w.y = cvt_pk_bf16(a[2], a[3]); *(u32x2_t*)(hn + off + bj * HALF + n * 16) = w; } }
                if (NEXT) { sq += __shfl_xor(sq, 16); sq += __shfl_xor(sq, 32); if (fq == 0) atomicAdd(ssq + row, sq); }
            }
    }
};
struct EpiProj {
    static constexpr bool PERM = true, AFTER_DRAIN = false;
    bf16_t* O; const float* ropec; const float* ropes; float c2; const float* ss; const float* bias;
    __device__ __forceinline__ void operator()(const f32x4 (&acc)[2][2][4][2], const Unit& u, int wr, int wc, int fr, int fq) const {
        const int row0 = u.pm * BM + wr * 64 + fr;
        f32x4 bia[2][2];
        { const float* bp = bias + (size_t)(u.pm >> 4) * 3584 + u.pn * BM + wc * 32 + 8 * fq;
          bia[0][0] = *(const f32x4*)bp; bia[0][1] = *(const f32x4*)(bp + 4); bia[1][0] = *(const f32x4*)(bp + HALF); bia[1][1] = *(const f32x4*)(bp + HALF + 4); }
        if (u.pn < 4) {
            const float sc = (u.pn >= 2) ? 0.125f : 1.0f;
            const int i0 = 8 * fq, colb = u.pn * BM + wc * 64 + i0;
#pragma unroll
            for (int ai = 0; ai < 2; ++ai)
#pragma unroll
                for (int m = 0; m < 4; ++m) {
                    const int row = row0 + ai * HALF + m * 16, pos = row & 4095;
                    const f32x4 c0 = *(const f32x4*)(ropec + pos * 32 + i0), c1 = *(const f32x4*)(ropec + pos * 32 + i0 + 4);
                    const f32x4 s0 = *(const f32x4*)(ropes + pos * 32 + i0), s1 = *(const f32x4*)(ropes + pos * 32 + i0 + 4);
                    const float ri = __builtin_amdgcn_rsqf(ss[row] * (1.0f / 1024.0f) + 1e-6f);
                    const f32x4 xa = acc[ai][0][m][0] * ri + bia[0][0], xb = acc[ai][0][m][1] * ri + bia[0][1], ya = acc[ai][1][m][0] * ri + bia[1][0], yb = acc[ai][1][m][1] * ri + bia[1][1];
                    const f32x4 o1a = (xa * c0 - ya * s0) * sc, o1b = (xb * c1 - yb * s1) * sc, o2a = (xa * s0 + ya * c0) * sc, o2b = (xb * s1 + yb * c1) * sc;
                    bf16_t* rowp = O + (size_t)row * 3584 + colb;
                    u32x4 w; w.x = cvt_pk_bf16(o1a[0], o1a[1]); w.y = cvt_pk_bf16(o1a[2], o1a[3]); w.z = cvt_pk_bf16(o1b[0], o1b[1]); w.w = cvt_pk_bf16(o1b[2], o1b[3]);
                    *(u32x4*)rowp = w;
                    w.x = cvt_pk_bf16(o2a[0], o2a[1]); w.y = cvt_pk_bf16(o2a[2], o2a[3]); w.z = cvt_pk_bf16(o2b[0], o2b[1]); w.w = cvt_pk_bf16(o2b[2], o2b[3]);
                    *(u32x4*)(rowp + 32) = w;
                }
        } else {
            const int kind = (u.pn == 6 || u.pn == 7) ? 1 : ((u.pn == 8 || u.pn == 9) ? 2 : 0);
            const int col0 = u.pn * BM + wc * 32 + 8 * fq;
#pragma unroll
            for (int ai = 0; ai < 2; ++ai)
#pragma unroll
                for (int m = 0; m < 4; ++m) {
                    bf16_t* rowp = O + (size_t)(row0 + ai * HALF + m * 16) * 3584 + col0;
                    const float ri = __builtin_amdgcn_rsqf(ss[row0 + ai * HALF + m * 16] * (1.0f / 1024.0f) + 1e-6f);
#pragma unroll
                    for (int bj = 0; bj < 2; ++bj) {
                        f32x4 v0 = acc[ai][bj][m][0] * ri + bia[bj][0], v1 = acc[ai][bj][m][1] * ri + bia[bj][1];
                        if (kind == 1) {
#pragma unroll
                            for (int e = 0; e < 4; ++e) { v0[e] = fast_silu(v0[e]); v1[e] = fast_silu(v1[e]); }
                        } else if (kind == 2) { v0 = v0 * c2; v1 = v1 * c2; }
                        u32x4 w; w.x = cvt_pk_bf16(v0[0], v0[1]); w.y = cvt_pk_bf16(v0[2], v0[3]); w.z = cvt_pk_bf16(v1[0], v1[1]); w.w = cvt_pk_bf16(v1[2], v1[3]);
                        *(u32x4*)(rowp + bj * HALF) = w;
                    }
                }
        }
    }
};

template <class Epi, class Sched, bool ALIGN_EPI = false, bool SP2 = false>
__device__ __forceinline__ void gemm_phase(PG8_LAS unsigned char* lds, const Gemm g, const Sched& S, const Epi& E) {
    int tid_l = threadIdx.x; asm volatile("" : "+v"(tid_l));
    const int tid = tid_l, wid = __builtin_amdgcn_readfirstlane(tid >> 6), lane = tid & 63, wr = wid >> 2, wc = wid & 3, fr = lane & 15, fq = lane >> 4;
    const int K = g.K, nt = K / BK;
    unsigned voffA[2], voffB[2];
#pragma unroll
    for (int i = 0; i < 2; ++i) { int R, C; stage_rc(tid * 16 + i * 8192, R, C); const int Rb = Epi::PERM ? ((R & ~31) + perm32(R & 31)) : R;
        voffA[i] = (unsigned)(R * K + C) * 2u; voffB[i] = (unsigned)(Rb * K + C) * 2u; }
    const size_t kstep = (size_t)(BK * 2);
    const size_t hstep = (size_t)HALF * K * 2;
    const size_t tstep = 2 * hstep;
    const unsigned ldsw = (unsigned)wid * 1024u;
    const int aoff = lds_byte(wr * 64 + fr, fq * 8), boff = lds_byte(wc * 32 + fr, fq * 8);
#define PG8_SA(b, h) (((b) * 2 + (h)) * HTB)
#define PG8_SB(b, h) ((4 + (b) * 2 + (h)) * HTB)
#define PG8_STAGE(bufoff, gbase, voff) do { _Pragma("unroll") for (int _i = 0; _i < 2; ++_i) \
        __builtin_amdgcn_global_load_lds((const unsigned*)((const char*)(gbase) + (voff)[_i]), (PG8_LAS unsigned*)(lds + (bufoff) + ldsw + _i * 8192), 16, 0, 0); } while (0)
#define PG8_LDA(dst, b, h) do { _Pragma("unroll") for (int m = 0; m < 4; ++m) _Pragma("unroll") for (int k = 0; k < 2; ++k) dst[m][k] = *(const PG8_LAS bf16x8*)(lds + PG8_SA(b, h) + aoff + m * 2048 + k * 1024); } while (0)
#define PG8_LDB(dst, b, h) do { _Pragma("unroll") for (int n = 0; n < 2; ++n) _Pragma("unroll") for (int k = 0; k < 2; ++k) dst[n][k] = *(const PG8_LAS bf16x8*)(lds + PG8_SB(b, h) + boff + n * 2048 + k * 1024); } while (0)
#define PG8_MMA(ai, bj, At, Bt) do { __builtin_amdgcn_s_setprio(1); _Pragma("unroll") for (int m = 0; m < 4; ++m) _Pragma("unroll") for (int n = 0; n < 2; ++n) _Pragma("unroll") for (int k = 0; k < 2; ++k) \
        acc[ai][bj][m][n] = __builtin_amdgcn_mfma_f32_16x16x32_bf16(Bt[n][k], At[m][k], acc[ai][bj][m][n], 0, 0, 0); __builtin_amdgcn_s_setprio(0); } while (0)
#define PG8_WAIT_V(n) asm volatile("s_waitcnt vmcnt(" #n ")" ::: "memory")
#define PG8_WAIT_L(n) asm volatile("s_waitcnt lgkmcnt(" #n ")" ::: "memory")
#define PG8_BAR __builtin_amdgcn_s_barrier()
#define PG8_SCHED __builtin_amdgcn_sched_barrier(0)
    Unit cur, nxt; int ui = 0;
    if (!S.next(0, cur)) return;
    f32x4 acc[2][2][4][2];
#pragma unroll
    for (int a = 0; a < 2; ++a)
#pragma unroll
        for (int b = 0; b < 2; ++b)
#pragma unroll
            for (int m = 0; m < 4; ++m)
#pragma unroll
                for (int n = 0; n < 2; ++n) acc[a][b][m][n] = (f32x4){0.f, 0.f, 0.f, 0.f};
    bf16x8 At[4][2], B0[2][2], B1[2][2];
    const char* cA = (const char*)g.A + (size_t)cur.pm * tstep; const char* cB = (const char*)g.Bt + (size_t)cur.pn * tstep;
    S.a_ready(cur);
    if constexpr (SP2) {
        PG8_STAGE(PG8_SB(0, 0), cB, voffB); PG8_STAGE(PG8_SB(0, 1), cB + hstep, voffB); PG8_STAGE(PG8_SA(0, 0), cA, voffA); PG8_STAGE(PG8_SA(0, 1), cA + hstep, voffA);
        if (wr == 1) PG8_BAR;
        PG8_WAIT_V(2); PG8_BAR;
        PG8_STAGE(PG8_SB(1, 0), cB + kstep, voffB); PG8_STAGE(PG8_SA(1, 0), cA + kstep, voffA); PG8_STAGE(PG8_SB(1, 1), cB + hstep + kstep, voffB);
        PG8_WAIT_V(6); PG8_BAR;
    } else {
        PG8_STAGE(PG8_SB(0, 0), cB, voffB); PG8_STAGE(PG8_SA(0, 0), cA, voffA); PG8_STAGE(PG8_SB(0, 1), cB + hstep, voffB); PG8_STAGE(PG8_SA(0, 1), cA + hstep, voffA);
        if (wr == 1) PG8_BAR;
        PG8_WAIT_V(4); PG8_BAR;
        PG8_STAGE(PG8_SB(1, 0), cB + kstep, voffB); PG8_STAGE(PG8_SA(1, 0), cA + kstep, voffA); PG8_STAGE(PG8_SB(1, 1), cB + hstep + kstep, voffB);
        PG8_WAIT_V(6); PG8_BAR;
    }
    for (;;) {
        const bool has_next = S.next(ui + 1, nxt);
        const char* nA = has_next ? (const char*)g.A + (size_t)nxt.pm * tstep : cA; const char* nB = has_next ? (const char*)g.Bt + (size_t)nxt.pn * tstep : cB;
        for (int t = 0; t < nt; t += 2) {
            const bool last = (t == nt - 2);
            const char* a1 = cA + (size_t)(t + 1) * kstep;
            const char* a2 = last ? nA : cA + (size_t)(t + 2) * kstep; const char* b2 = last ? nB : cB + (size_t)(t + 2) * kstep;
            const char* a3 = a2 + kstep; const char* b3 = b2 + kstep;
            if (last && has_next) S.a_ready(nxt);
            if constexpr (SP2) {
            PG8_LDB(B0, 0, 0); PG8_LDB(B1, 0, 1); PG8_SCHED; PG8_LDA(At, 0, 0); PG8_STAGE(PG8_SA(1, 1), a1 + hstep, voffA);
            PG8_WAIT_V(8); PG8_WAIT_L(0); PG8_BAR; PG8_MMA(0, 0, At, B0); PG8_MMA(0, 1, At, B1); PG8_BAR; PG8_SCHED;
            PG8_LDA(At, 0, 1); PG8_STAGE(PG8_SB(0, 0), b2, voffB); PG8_STAGE(PG8_SB(0, 1), b2 + hstep, voffB); PG8_STAGE(PG8_SA(0, 0), a2, voffA);
            PG8_WAIT_V(8); PG8_WAIT_L(0); PG8_BAR; PG8_MMA(1, 0, At, B0); PG8_MMA(1, 1, At, B1); PG8_BAR; PG8_SCHED;
            PG8_LDB(B0, 1, 0); PG8_LDB(B1, 1, 1); PG8_SCHED; PG8_LDA(At, 1, 0); PG8_STAGE(PG8_SA(0, 1), a2 + hstep, voffA);
            PG8_WAIT_V(8); PG8_WAIT_L(0); PG8_BAR; PG8_MMA(0, 0, At, B0); PG8_MMA(0, 1, At, B1); PG8_BAR; PG8_SCHED;
            PG8_LDA(At, 1, 1); PG8_STAGE(PG8_SB(1, 0), b3, voffB); PG8_STAGE(PG8_SB(1, 1), b3 + hstep, voffB); PG8_STAGE(PG8_SA(1, 0), a3, voffA);
            PG8_WAIT_V(8); PG8_WAIT_L(0); PG8_BAR; PG8_MMA(1, 0, At, B0); PG8_MMA(1, 1, At, B1); PG8_BAR; PG8_SCHED;
            } else {
            PG8_LDB(B0, 0, 0); PG8_SCHED; PG8_LDA(At, 0, 0); PG8_STAGE(PG8_SA(1, 1), a1 + hstep, voffA);
            PG8_WAIT_L(8); PG8_BAR; PG8_WAIT_L(0); PG8_MMA(0, 0, At, B0); PG8_BAR; PG8_SCHED;
            PG8_LDB(B1, 0, 1); PG8_STAGE(PG8_SB(0, 0), b2, voffB);
            PG8_BAR; PG8_WAIT_L(0); PG8_MMA(0, 1, At, B1); PG8_BAR;
            PG8_LDA(At, 0, 1); PG8_STAGE(PG8_SA(0, 0), a2, voffA);
            PG8_BAR; PG8_WAIT_L(0); PG8_MMA(1, 0, At, B0); PG8_BAR; PG8_SCHED;
            PG8_STAGE(PG8_SB(0, 1), b2 + hstep, voffB);
            PG8_WAIT_V(6); PG8_BAR; PG8_MMA(1, 1, At, B1); PG8_BAR;
            PG8_LDB(B0, 1, 0); PG8_SCHED; PG8_LDA(At, 1, 0); PG8_STAGE(PG8_SA(0, 1), a2 + hstep, voffA);
            PG8_WAIT_L(8); PG8_BAR; PG8_WAIT_L(0); PG8_MMA(0, 0, At, B0); PG8_BAR; PG8_SCHED;
            PG8_LDB(B1, 1, 1); PG8_STAGE(PG8_SB(1, 0), b3, voffB);
            PG8_BAR; PG8_WAIT_L(0); PG8_MMA(0, 1, At, B1); PG8_BAR;
            PG8_LDA(At, 1, 1); PG8_STAGE(PG8_SA(1, 0), a3, voffA);
            PG8_BAR; PG8_WAIT_L(0); PG8_MMA(1, 0, At, B0); PG8_BAR; PG8_SCHED;
            PG8_STAGE(PG8_SB(1, 1), b3 + hstep, voffB);
            PG8_WAIT_V(6); PG8_BAR; PG8_MMA(1, 1, At, B1); PG8_BAR;
            }
        }
        if constexpr (ALIGN_EPI) { if (wr == 0) PG8_BAR; }
        if constexpr (!Epi::AFTER_DRAIN) { E(acc, cur, wr, wc, fr, fq); S.done(cur); }
        if (!has_next) break;
#pragma unroll
        for (int a = 0; a < 2; ++a)
#pragma unroll
            for (int b = 0; b < 2; ++b)
#pragma unroll
                for (int m = 0; m < 4; ++m)
#pragma unroll
                    for (int n = 0; n < 2; ++n) acc[a][b][m][n] = (f32x4){0.f, 0.f, 0.f, 0.f};
        cur = nxt; cA = nA; cB = nB; ++ui;
        if constexpr (ALIGN_EPI) { if (wr == 1) PG8_BAR; }
    }
    PG8_WAIT_V(0);
    if constexpr (!ALIGN_EPI) { if (wr == 0) PG8_BAR; }
    PG8_BAR;
    if constexpr (Epi::AFTER_DRAIN) { E.fused(acc, cur, wr, wc, fr, fq, lds, wid, lane); S.done(cur); }
#undef PG8_SA
#undef PG8_SB
#undef PG8_STAGE
#undef PG8_LDA
#undef PG8_LDB
#undef PG8_MMA
#undef PG8_WAIT_V
#undef PG8_WAIT_L
#undef PG8_BAR
#undef PG8_SCHED
}
}
#include <hip/hip_bf16.h>
#include <cmath>
namespace attn_body {
using bf16=__hip_bfloat16;
using bf16x8=__attribute__((ext_vector_type(8)))short;
using s16x4=__attribute__((ext_vector_type(4)))short;
using f32x16=__attribute__((ext_vector_type(16)))float;
using u32x4=__attribute__((ext_vector_type(4)))unsigned;
constexpr int SEQ=4096,D=64,PQ=3584,PO=1024;
constexpr int NW=8,QBLK=32,QB=QBLK*NW,KVBLK=64,NQB=SEQ/QB;
constexpr int ATTN_UNIT_ROWS=QB;
__device__ __forceinline__ int crow(int r,int hi){return (r&3)+8*(r>>2)+4*hi;}
#define SBAR() __builtin_amdgcn_sched_barrier(0)
typedef __attribute__((address_space(3))) const float* lds_cfptr;
__device__ __forceinline__ void cmask(f32x16&p0,f32x16&p1,int jb,int qrel,int hi,lds_cfptr rt){
  const float NEG=-INFINITY; const int base=qrel-64*jb-4*hi;
  lds_cfptr a=rt+(383-base);
  #pragma unroll
  for(int g=0;g<4;++g){
    #pragma unroll
    for(int rr=0;rr<4;++rr){const int r=4*g+rr,o=(r&3)+8*(r>>2);
      const float d0=a[o],d1=a[o+32];
      p0[r]=(base-o<0)?NEG:p0[r]+d0; p1[r]=(base-o-32<0)?NEG:p1[r]+d1;}
    __builtin_amdgcn_sched_barrier(0);
  }
}

constexpr int NSLOT=3, SLOTB=8192;
constexpr int LDS_K=0, LDS_V=NSLOT*SLOTB, LDS_WS=2*NSLOT*SLOTB, LDS_OST=LDS_WS+NW*64*4, LDS_TAB=LDS_OST+NW*4096, LDS_BYTES=LDS_TAB+2560;
constexpr float C2=0.125f*1.4426950408889634f;
__device__ __forceinline__ void glds16(const void*gsrc,unsigned lds_dst){unsigned keep;
  asm volatile("s_mov_b32 %0, m0\n\ts_mov_b32 m0, %2\n\ts_nop 0\n\tglobal_load_lds_dwordx4 %1, off\n\ts_mov_b32 m0, %0":"=&s"(keep):"v"(gsrc),"s"(lds_dst):"memory");}
__device__ __forceinline__ float max3f(float a,float b,float c){float r;asm("v_max3_f32 %0, %1, %2, %3":"=v"(r):"v"(a),"v"(b),"v"(c));return r;}
__device__ __forceinline__ float max2f(float a,float b){float r;asm("v_max_f32_e32 %0, %1, %2":"=v"(r):"v"(a),"v"(b));return r;}
__device__ __forceinline__ float fadd_s(float a,float b){float r;asm("v_add_f32_e32 %0, %1, %2":"=v"(r):"v"(a),"v"(b));return r;}
__device__ __forceinline__ float fsub_s(float a,float b){float r;asm("v_sub_f32_e32 %0, %1, %2":"=v"(r):"v"(a),"v"(b));return r;}
typedef float f32x2_t __attribute__((ext_vector_type(2))); typedef __bf16 bf16x2_t __attribute__((ext_vector_type(2)));
__device__ __forceinline__ unsigned cvtpk_s(float lo,float hi){f32x2_t v={lo,hi};bf16x2_t b=__builtin_convertvector(v,bf16x2_t);return __builtin_bit_cast(unsigned,b);}
#define WAIT_BAR(N) asm volatile("s_waitcnt vmcnt(" #N ") lgkmcnt(0)\n\ts_barrier":::"memory")

__device__ __forceinline__ void qkt(f32x16&p0,f32x16&p1,const char*Kslot,const bf16x8*qr,const f32x16&negm,int r32,int hi){
  const char*kb=Kslot+hi*1024+r32*16;
  #pragma unroll
  for(int d0=0;d0<4;++d0){
    const bf16x8 b0=*reinterpret_cast<const bf16x8*>(kb+d0*2048);
    const bf16x8 b1=*reinterpret_cast<const bf16x8*>(kb+d0*2048+512);
    if(d0==0){p0=__builtin_amdgcn_mfma_f32_32x32x16_bf16(b0,qr[0],negm,0,0,0);p1=__builtin_amdgcn_mfma_f32_32x32x16_bf16(b1,qr[0],negm,0,0,0);}
    else{p0=__builtin_amdgcn_mfma_f32_32x32x16_bf16(b0,qr[d0],p0,0,0,0);p1=__builtin_amdgcn_mfma_f32_32x32x16_bf16(b1,qr[d0],p1,0,0,0);}}
}
typedef __attribute__((address_space(3))) const char* lds_cptr;
typedef short v4i16_t __attribute__((ext_vector_type(4)));
__device__ __forceinline__ void kload8(bf16x8*kf,lds_cptr kp){
  kf[0]=*(const __attribute__((address_space(3))) bf16x8*)(kp);      kf[1]=*(const __attribute__((address_space(3))) bf16x8*)(kp+512);
  kf[2]=*(const __attribute__((address_space(3))) bf16x8*)(kp+2048); kf[3]=*(const __attribute__((address_space(3))) bf16x8*)(kp+2560);
  kf[4]=*(const __attribute__((address_space(3))) bf16x8*)(kp+4096); kf[5]=*(const __attribute__((address_space(3))) bf16x8*)(kp+4608);
  kf[6]=*(const __attribute__((address_space(3))) bf16x8*)(kp+6144); kf[7]=*(const __attribute__((address_space(3))) bf16x8*)(kp+6656);
}
__device__ __forceinline__ void kload2(bf16x8*kf,lds_cptr kp,int j){ kf[2*j]=*(const __attribute__((address_space(3))) bf16x8*)(kp+j*2048); kf[2*j+1]=*(const __attribute__((address_space(3))) bf16x8*)(kp+j*2048+512); }
__device__ __forceinline__ s16x4 vtr(lds_cptr p){ return __builtin_bit_cast(s16x4,__builtin_amdgcn_ds_read_tr16_b64_v4i16((__attribute__((address_space(3))) v4i16_t*)p)); }
__device__ __forceinline__ float rowmax(const f32x16&p0,const f32x16&p1){
  float a=max3f(p0[0],p0[1],p1[0]),b=max3f(p0[2],p0[3],p1[1]);a=max3f(a,p1[2],p1[3]);
  #pragma unroll
  for(int r=4;r<16;r+=4){a=max3f(a,p0[r],p0[r+1]);b=max3f(b,p0[r+2],p0[r+3]);a=max3f(a,p1[r],p1[r+1]);b=max3f(b,p1[r+2],p1[r+3]);}
  const float m=max2f(a,b);
  auto rr=__builtin_amdgcn_permlane32_swap(__float_as_uint(m),__float_as_uint(m),false,false);
  return max2f(__uint_as_float(rr[0]),__uint_as_float(rr[1]));
}
__device__ __forceinline__ void pv(f32x16*o,int vb,bf16x8 pa0,bf16x8 pa1,bf16x8 pa2,bf16x8 pa3){
  #pragma unroll
  for(int d0=0;d0<2;++d0){s16x4 lo[4],hi[4];
    #pragma unroll
    for(int ks=0;ks<4;++ks){
      asm volatile("ds_read_b64_tr_b16 %0,%1 offset:%c2":"=&v"(lo[ks]):"v"(vb),"i"(d0*4096+ks*1024):"memory");
      asm volatile("ds_read_b64_tr_b16 %0,%1 offset:%c2":"=&v"(hi[ks]):"v"(vb),"i"(d0*4096+ks*1024+512):"memory");}
    asm volatile("s_waitcnt lgkmcnt(0)":::"memory");SBAR();
    #define PK(k) (bf16x8){lo[k][0],lo[k][1],lo[k][2],lo[k][3],hi[k][0],hi[k][1],hi[k][2],hi[k][3]}
    o[d0]=__builtin_amdgcn_mfma_f32_32x32x16_bf16(pa0,PK(0),o[d0],0,0,0);
    o[d0]=__builtin_amdgcn_mfma_f32_32x32x16_bf16(pa1,PK(1),o[d0],0,0,0);
    o[d0]=__builtin_amdgcn_mfma_f32_32x32x16_bf16(pa2,PK(2),o[d0],0,0,0);
    o[d0]=__builtin_amdgcn_mfma_f32_32x32x16_bf16(pa3,PK(3),o[d0],0,0,0);
    #undef PK
  }
}

#ifndef ATTN_STORE16
#define ATTN_STORE16(p,v) (*(u32x4*)(p)=(v))
#endif
template<int THRL> __device__ __forceinline__ void attn_unit(int qb,const bf16*Qb,const bf16*__restrict__ Kh,const bf16*__restrict__ Vh,bf16*Ob,const float*tabg,float cfar,char*shm){
  int tid_l=threadIdx.x; asm volatile("":"+v"(tid_l));
  const int tid=tid_l,lane=tid&63,r32=lane&31,hi=lane>>5; const int wid=__builtin_amdgcn_readfirstlane(tid>>6);
  const int q0=qb*QB;
  const bf16*Qw=Qb+(long)(q0+wid*QBLK)*PQ;
  const unsigned lds0=(unsigned)(uintptr_t)shm;
  float*wsf=(float*)(shm+LDS_WS)+wid*64;
  const bf16*ksrc=Kh+(long)lane*PQ+wid*8;
  const bf16*vsrc=Vh+(long)(16*(wid&3)+(lane>>2))*PQ+(wid>>2)*32+(lane&3)*8;
  const unsigned kdst=lds0+LDS_K+wid*1024, vdst=lds0+LDS_V+wid*1024;
  #define DMA_K(t,slot) glds16(ksrc+(long)(t)*KVBLK*PQ,(unsigned)__builtin_amdgcn_readfirstlane(kdst+(slot)))
  #define DMA_V(t,slot) glds16(vsrc+(long)(t)*KVBLK*PQ,(unsigned)__builtin_amdgcn_readfirstlane(vdst+(slot)))
  const int vb0=(int)(lds0+LDS_V)+((lane>>4)&1)*32+(lane&3)*8+(4*hi+((lane&15)>>2))*64;
  const char*Kbase=shm+LDS_K; bf16x8 kf[8];
  const lds_cptr shm3=(lds_cptr)shm; const lds_cptr kp0=shm3+LDS_K+hi*1024+r32*16; const lds_cptr vp0=shm3+LDS_V+((lane>>4)&1)*32+(lane&3)*8+(4*hi+((lane&15)>>2))*64;
  const int NT=(q0+QB)/KVBLK;
  const lds_cfptr tab=(lds_cfptr)((lds_cptr)shm+LDS_TAB);
  for(int j=tid;j<640;j+=512){const int n=383-j; ((__attribute__((address_space(3))) float*)((__attribute__((address_space(3))) char*)shm+LDS_TAB))[j]=(n>=0&&n<113)?tabg[n]:0.f;}
  DMA_K(0,0);DMA_V(0,0);DMA_K(1,SLOTB);
  bf16x8 qr[4];
  #pragma unroll
  for(int d0=0;d0<4;++d0)qr[d0]=*reinterpret_cast<const bf16x8*>(&Qw[(long)r32*PQ+d0*16+hi*8]);
  float mhat=0.f,l_reg=0.f;f32x16 o[2];o[0]=f32x16{};o[1]=f32x16{};f32x16 negm;
  #pragma unroll
  for(int r=0;r<16;++r)negm[r]=cfar;
  asm volatile("":"+v"(negm));
  const int qrel=wid*QBLK+r32;
  #define CMASK(P0,P1,t) do{int jb_=(t)-(NT-4); if(jb_>=-2)cmask(P0,P1,jb_,qrel,hi,tab);}while(0)
  bool resc=false;
  #define START(P0,P1) do{ const float rm=rowmax(P0,P1); resc=false; \
    { const float dl=rm; mhat=fadd_s(mhat,dl); \
      _Pragma("unroll") for(int r=0;r<16;++r){P0[r]=fsub_s(P0[r],dl);P1[r]=fsub_s(P1[r],dl);} \
      _Pragma("unroll") for(int r=0;r<16;++r)negm[r]=cfar-mhat; asm volatile("":"+v"(negm)); } \
    _Pragma("unroll") for(int r=0;r<16;++r)P0[r]=__builtin_amdgcn_exp2f(P0[r]); }while(0)
  #define RESC() do{ if(resc){ asm volatile("s_waitcnt lgkmcnt(0)":::"memory"); \
      _Pragma("unroll") for(int d_=0;d_<2;++d_) _Pragma("unroll") for(int r=0;r<16;++r)o[d_][r]*=wsf[crow(r,hi)]; } }while(0)
  f32x16 pA0,pA1,pB0,pB1;
  int sl_prev=0,sl_cur=0,sl_next=SLOTB;
  #define ROT() do{sl_prev=sl_cur;sl_cur=sl_next;sl_next=(sl_next==(NSLOT-1)*SLOTB)?0:sl_next+SLOTB;}while(0)
  DMA_K(2,2*SLOTB);
  WAIT_BAR(3);
  qkt(pA0,pA1,Kbase,qr,negm,r32,hi);asm volatile("s_nop 15\n\ts_nop 7":"+v"(pA0),"+v"(pA1));CMASK(pA0,pA1,0);
  START(pA0,pA1);
  _Pragma("unroll") for(int r=0;r<16;++r)pA1[r]=__builtin_amdgcn_exp2f(pA1[r]);
  WAIT_BAR(0);
  DMA_K(3,0);DMA_V(1,SLOTB);
  ROT();
  kload8(kf,kp0+sl_cur);
  WAIT_BAR(2);
  s16x4 vlo[8],vhi[8]; u32x4 pw0,pw1,pw2,pw3;
  #define PKW(P,B) cvtpk_s(P[B],P[B+1])
  #define PAF(k) __builtin_bit_cast(bf16x8,pw##k)
  #define VFR(i) (bf16x8){vlo[i][0],vlo[i][1],vlo[i][2],vlo[i][3],vhi[i][0],vhi[i][1],vhi[i][2],vhi[i][3]}
  #define PIN(x) asm volatile("":"+v"(x))
  #define MX3(a,b,c) __builtin_fmaxf(__builtin_fmaxf((a),(b)),(c))
  #define GAPA(MF,A0,A1,A2,A3,W0,W1,PW) do{ MF; sacc+=A0; sacc+=A1; sacc+=A2; sacc+=A3; PIN(sacc); W0; W1; PIN(PW); SBAR(); }while(0)
  #define EX(v) __builtin_amdgcn_exp2f(v)
  #define GAPB(MF,X,B) do{ MF; X[B]=EX(X[B]); X[B+1]=EX(X[B+1]); X[B+2]=EX(X[B+2]); X[B+3]=EX(X[B+3]); PIN(X); SBAR(); }while(0)
  #define VRD(i) do{ vlo[i]=vtr(vp_+(((i)>>2)*4096+((i)&3)*1024)); vhi[i]=vtr(vp_+(((i)>>2)*4096+((i)&3)*1024+512)); }while(0)
  #define KRD(G,j) do{ if(G){ kload2(kf,kp0+sl_next,j); SBAR(); } }while(0)
  #define STEP(C0,C1,P0,P1,t,GK,GV,GL) do{ SBAR(); \
    const lds_cptr vp_=vp0+sl_prev; \
    VRD(0); SBAR(); float sacc=(P0[0]+P0[1]); \
    GAPA(C0=__builtin_amdgcn_mfma_f32_32x32x16_bf16(kf[0],qr[0],negm,0,0,0), P0[2],P0[3],P0[4],P0[5],     pw0[0]=PKW(P0,0), pw0[1]=PKW(P0,2), pw0); \
    VRD(4); SBAR(); GAPA(C1=__builtin_amdgcn_mfma_f32_32x32x16_bf16(kf[1],qr[0],negm,0,0,0), P0[6],P0[7],P0[8],P0[9],     pw0[2]=PKW(P0,4), pw0[3]=PKW(P0,6), pw0); \
    VRD(1); SBAR(); GAPA(C0=__builtin_amdgcn_mfma_f32_32x32x16_bf16(kf[2],qr[1],C0,0,0,0),   P0[10],P0[11],P0[12],P0[13], pw1[0]=PKW(P0,8), pw1[1]=PKW(P0,10), pw1); \
    VRD(5); SBAR(); GAPA(C1=__builtin_amdgcn_mfma_f32_32x32x16_bf16(kf[3],qr[1],C1,0,0,0),   P0[14],P0[15],P1[0],P1[1],   pw1[2]=PKW(P0,12),pw1[3]=PKW(P0,14), pw1); \
    VRD(2); SBAR(); GAPA(C0=__builtin_amdgcn_mfma_f32_32x32x16_bf16(kf[4],qr[2],C0,0,0,0),   P1[2],P1[3],P1[4],P1[5],     pw2[0]=PKW(P1,0), pw2[1]=PKW(P1,2), pw2); \
    VRD(6); SBAR(); GAPA(C1=__builtin_amdgcn_mfma_f32_32x32x16_bf16(kf[5],qr[2],C1,0,0,0),   P1[6],P1[7],P1[8],P1[9],     pw2[2]=PKW(P1,4), pw2[3]=PKW(P1,6), pw2); \
    VRD(3); SBAR(); GAPA(C0=__builtin_amdgcn_mfma_f32_32x32x16_bf16(kf[6],qr[3],C0,0,0,0),   P1[10],P1[11],P1[12],P1[13], pw3[0]=PKW(P1,8), pw3[1]=PKW(P1,10), pw3); \
    VRD(7); SBAR(); GAPA(C1=__builtin_amdgcn_mfma_f32_32x32x16_bf16(kf[7],qr[3],C1,0,0,0),   P1[14],P1[15],0.f,0.f,       pw3[2]=PKW(P1,12),pw3[3]=PKW(P1,14), pw3); \
    l_reg+=sacc; \
    if(GK){DMA_K((t)+3,sl_cur);} if(GV){DMA_V((t)+1,sl_next);} \
    CMASK(C0,C1,t); \
    { float a=MX3(C0[0],C0[1],C1[0]),b=MX3(C0[2],C0[3],C1[1]); a=MX3(a,C1[2],C1[3]); \
      _Pragma("unroll") for(int r=4;r<16;r+=4){a=MX3(a,C0[r],C0[r+1]);b=MX3(b,C0[r+2],C0[r+3]);a=MX3(a,C1[r],C1[r+1]);b=MX3(b,C1[r+2],C1[r+3]);} \
      float rm=__builtin_fmaxf(a,b); { auto rr=__builtin_amdgcn_permlane32_swap(__float_as_uint(rm),__float_as_uint(rm),false,false); rm=__builtin_fmaxf(__uint_as_float(rr[0]),__uint_as_float(rr[1])); } \
      resc=false; \
      if(__builtin_expect(__any(rm>(float)THRL),0)){ const float dl=__builtin_fmaxf(rm,0.f); mhat+=dl; \
        _Pragma("unroll") for(int r=0;r<16;++r){C0[r]-=dl;C1[r]-=dl;} \
        _Pragma("unroll") for(int r=0;r<16;++r)negm[r]=cfar-mhat; asm volatile("":"+v"(negm)); \
        const float f=__builtin_amdgcn_exp2f(-dl); l_reg*=f; if(hi==0)wsf[r32]=f; resc=true; } } \
    SBAR(); \
    GAPB(o[0]=__builtin_amdgcn_mfma_f32_32x32x16_bf16(PAF(0),VFR(0),o[0],0,0,0), C0,0); \
    GAPB(o[1]=__builtin_amdgcn_mfma_f32_32x32x16_bf16(PAF(0),VFR(4),o[1],0,0,0), C0,4); \
    KRD(GL,0); GAPB(o[0]=__builtin_amdgcn_mfma_f32_32x32x16_bf16(PAF(1),VFR(1),o[0],0,0,0), C0,8); \
    KRD(GL,1); GAPB(o[1]=__builtin_amdgcn_mfma_f32_32x32x16_bf16(PAF(1),VFR(5),o[1],0,0,0), C0,12); \
    KRD(GL,2); GAPB(o[0]=__builtin_amdgcn_mfma_f32_32x32x16_bf16(PAF(2),VFR(2),o[0],0,0,0), C1,0); \
    KRD(GL,3); GAPB(o[1]=__builtin_amdgcn_mfma_f32_32x32x16_bf16(PAF(2),VFR(6),o[1],0,0,0), C1,4); \
    GAPB(o[0]=__builtin_amdgcn_mfma_f32_32x32x16_bf16(PAF(3),VFR(3),o[0],0,0,0), C1,8); \
    GAPB(o[1]=__builtin_amdgcn_mfma_f32_32x32x16_bf16(PAF(3),VFR(7),o[1],0,0,0), C1,12); \
    }while(0)
  int t=1;
  #undef CMASK
  #define CMASK(P0,P1,t) do{}while(0)
  for(;t+7<NT;t+=2){
    STEP(pB0,pB1,pA0,pA1,t,true,true,true);     WAIT_BAR(2); RESC(); ROT();
    STEP(pA0,pA1,pB0,pB1,t+1,true,true,true);   WAIT_BAR(2); RESC(); ROT();
  }
  #undef CMASK
  #define CMASK(P0,P1,t) do{int jb_=(t)-(NT-4); if(jb_>=-2)cmask(P0,P1,jb_,qrel,hi,tab);}while(0)
  #define ENDW(tt) do{ if((tt)+3<NT){WAIT_BAR(2);} else if((tt)+2<NT){WAIT_BAR(1);} else {WAIT_BAR(0);} }while(0)
  for(;t+1<NT;t+=2){
    STEP(pB0,pB1,pA0,pA1,t,(t+3<NT),(t+1<NT),(t+1<NT));       ENDW(t);   RESC(); ROT();
    STEP(pA0,pA1,pB0,pB1,t+1,(t+4<NT),(t+2<NT),(t+2<NT));     ENDW(t+1); RESC(); ROT();
  }
  STEP(pB0,pB1,pA0,pA1,NT-1,false,false,false); RESC();
  { float sacc=pB0[0]+pB0[1]; _Pragma("unroll") for(int r=2;r<16;++r)sacc+=pB0[r]; _Pragma("unroll") for(int r=0;r<16;++r)sacc+=pB1[r]; l_reg+=sacc;
    pw0=(u32x4){PKW(pB0,0),PKW(pB0,2),PKW(pB0,4),PKW(pB0,6)};pw1=(u32x4){PKW(pB0,8),PKW(pB0,10),PKW(pB0,12),PKW(pB0,14)};pw2=(u32x4){PKW(pB1,0),PKW(pB1,2),PKW(pB1,4),PKW(pB1,6)};pw3=(u32x4){PKW(pB1,8),PKW(pB1,10),PKW(pB1,12),PKW(pB1,14)};
    SBAR(); pv(o,vb0+sl_cur,PAF(0),PAF(1),PAF(2),PAF(3)); }
  #undef PKW
  #undef PAF
  #undef VFR
  #undef PIN
  #undef MX3
  #undef GAPA
  #undef GAPB
  #undef EX
  #undef VRD
  #undef KRD
  #undef STEP
  #undef ENDW
  {auto rr=__builtin_amdgcn_permlane32_swap(__float_as_uint(l_reg),__float_as_uint(l_reg),false,false);l_reg=__uint_as_float(rr[0])+__uint_as_float(rr[1]);}
  if(hi==0)wsf[32+r32]=l_reg;asm volatile("s_waitcnt lgkmcnt(0)":::"memory");
  float rli[16];
  #pragma unroll
  for(int r=0;r<16;++r)rli[r]=__builtin_amdgcn_rcpf(wsf[32+crow(r,hi)]);
  bf16*Ow=Ob+(long)(q0+wid*QBLK)*PO;
  { bf16*stg=(bf16*)(shm+LDS_OST)+wid*2048;
    #pragma unroll
    for(int r=0;r<16;++r){const int orow=crow(r,hi);
      #pragma unroll
      for(int d0=0;d0<2;++d0)stg[orow*64+d0*32+r32]=__float2bfloat16(o[d0][r]*rli[r]);}
    asm volatile("s_waitcnt lgkmcnt(0)":::"memory");
    #pragma unroll
    for(int i=0;i<4;++i){const int row=i*8+(lane>>3),ch=lane&7; const u32x4 v=*(const u32x4*)(stg+row*64+ch*8); ATTN_STORE16(Ow+(long)row*PO+ch*8,v);} }
  asm volatile("s_waitcnt lgkmcnt(0)\n\ts_barrier":::"memory");
  #undef DMA_K
  #undef DMA_V
  #undef CMASK
  #undef START
  #undef RESC
  #undef ROT
}
constexpr int ATTN_LDS_BYTES=LDS_BYTES;
template<int THRL=8> __device__ __forceinline__ void attn_phase(char*lds,const bf16*P,bf16*O,const float*TAB,const float*CFAR,int grid,int block){
  const int vcu=(grid%8==0)?(block%8)*(grid/8)+block/8:block;
  for(int vh=vcu>>1;vh<128;vh+=(grid>>1)){
    const int half=vh&1,m=(vh>>1)&1,h=(vh>>2)&3,b=vh>>4;
    const bf16*Pb=P+(long)b*SEQ*PQ;
    const float cf=CFAR[h];
    for(int i=0;i<8;++i){ const int s=4*(vcu&1)+(i>>1); const int qb=(i&1)?15-s:s;
      attn_unit<THRL>(qb,Pb+2048+h*128+m*64,Pb+2560+h*128+m*64,Pb+3072+h*128+half*64,O+(long)b*SEQ*PO+((h*2+m)*2+half)*64,TAB+h*128,cf,lds); }
  }
}
#undef SBAR
#undef WAIT_BAR
}
namespace ret {
typedef short bf16x8 __attribute__((ext_vector_type(8)));
typedef short s16x4 __attribute__((ext_vector_type(4)));
typedef float f32x4 __attribute__((ext_vector_type(4)));
typedef unsigned u32x4 __attribute__((ext_vector_type(4)));
typedef unsigned u32x2 __attribute__((ext_vector_type(2)));
#define RLAS __attribute__((address_space(3)))
typedef RLAS unsigned char* ldsptr;
constexpr int RS = 72, PS = 136;
constexpr int OFF_Q = 0, OFF_K = 18432, OFF_KZ = 36864, OFF_V = 55296, OFF_RT = 73728, OFF_P = 82944, RET_LDS = 117760;
constexpr int NINP = 3584, SEQL = 4096;
__device__ __forceinline__ unsigned f2bf_(float f) { unsigned u = __builtin_bit_cast(unsigned, f); return (u + 0x7fffu + ((u >> 16) & 1u)) >> 16; }
__device__ __forceinline__ unsigned pk2_(float lo, float hi) { return f2bf_(lo) | (f2bf_(hi) << 16); }
__device__ __forceinline__ float bf2f_(unsigned h) { return __builtin_bit_cast(float, h << 16); }
__device__ __forceinline__ bf16x8 ldA(ldsptr base, int row, int col, int stride) { return *(const RLAS bf16x8*)(base + (row * stride + col) * 2); }
__device__ __forceinline__ bf16x8 ldT(ldsptr base, int k0, int n0, int c, int q) {
    typedef short v4i16_t __attribute__((ext_vector_type(4)));
    ldsptr p = base + ((k0 + 8 * q + (c >> 2)) * RS + n0 + 4 * (c & 3)) * 2;
    const s16x4 lo = __builtin_bit_cast(s16x4, __builtin_amdgcn_ds_read_tr16_b64_v4i16((RLAS v4i16_t*)p));
    const s16x4 hi = __builtin_bit_cast(s16x4, __builtin_amdgcn_ds_read_tr16_b64_v4i16((RLAS v4i16_t*)(p + 4 * RS * 2)));
    return (bf16x8){lo[0], lo[1], lo[2], lo[3], hi[0], hi[1], hi[2], hi[3]};
}
#define MFMA16(a, b, c) __builtin_amdgcn_mfma_f32_16x16x32_bf16((a), (b), (c), 0, 0, 0)

template <bool WITH_Q> __device__ __forceinline__ void stage(ldsptr lds, const unsigned short* Pb, int row0, int h, float l2g, int tid) {
#pragma unroll
    for (int u = 0; u < 2; ++u) {
        const int pid = tid + 512 * u, row = pid >> 3, cp = pid & 7;
        const unsigned short* src = Pb + (size_t)(row0 + row) * NINP + h * 64 + 8 * cp;
        const u32x4 kv = *(const u32x4*)(src + 512), vv = *(const u32x4*)(src + 1024);
        const int off = (row * RS + 8 * cp) * 2;
        if (WITH_Q) { const u32x4 qv = *(const u32x4*)src; *(RLAS u32x4*)(lds + OFF_Q + off) = qv; *(RLAS u32x4*)(lds + OFF_K + off) = kv; }
        *(RLAS u32x4*)(lds + OFF_V + off) = vv;
        const float z = __builtin_amdgcn_exp2f((float)(127 - row) * l2g);
        u32x4 kz;
        kz.x = pk2_(bf2f_(kv.x & 0xffffu) * z, bf2f_(kv.x >> 16) * z); kz.y = pk2_(bf2f_(kv.y & 0xffffu) * z, bf2f_(kv.y >> 16) * z);
        kz.z = pk2_(bf2f_(kv.z & 0xffffu) * z, bf2f_(kv.z >> 16) * z); kz.w = pk2_(bf2f_(kv.w & 0xffffu) * z, bf2f_(kv.w >> 16) * z);
        *(RLAS u32x4*)(lds + OFF_KZ + off) = kz;
    }
}
__device__ __forceinline__ void state_update(ldsptr lds, f32x4 (&acc_s)[2], float gc, int w, int c, int q) {
    const int dt = w >> 1, et0 = 2 * (w & 1);
    acc_s[0] = acc_s[0] * gc; acc_s[1] = acc_s[1] * gc;
#pragma unroll
    for (int ks = 0; ks < 4; ++ks) {
        const bf16x8 a = ldT(lds + OFF_KZ, 32 * ks, 16 * dt, c, q);
#pragma unroll
        for (int t2 = 0; t2 < 2; ++t2) acc_s[t2] = MFMA16(a, ldT(lds + OFF_V, 32 * ks, 16 * (et0 + t2), c, q), acc_s[t2]);
    }
}
__device__ __forceinline__ float head_l2g(int h) { return log1pf(-exp2f(-5.0f - (float)h)) * 1.4426950408889634f; }

__device__ __forceinline__ void phase_a(unsigned char* lds_, const unsigned short* PROJ, f32x4* GS, int grid, int block) {
    ldsptr lds = (ldsptr)lds_;
    int tid_l = threadIdx.x; asm volatile("" : "+v"(tid_l));
    const int tid = tid_l, lane = tid & 63, w = __builtin_amdgcn_readfirstlane(tid >> 6), c = lane & 15, q = lane >> 4;
    for (int uid = block; uid < 512; uid += grid) {
        const int bh = uid >> 3, g = uid & 7, b = bh >> 3, h = bh & 7;
        const float l2g = head_l2g(h), gc = exp2f(128.0f * l2g);
        const unsigned short* Pb = PROJ + (size_t)b * SEQL * NINP;
        f32x4 acc_s[2] = {(f32x4){0.f, 0.f, 0.f, 0.f}, (f32x4){0.f, 0.f, 0.f, 0.f}};
        for (int i = 0; i < 4; ++i) {
            stage<false>(lds, Pb, (4 * g + i) * 128, h, l2g, tid);
            __syncthreads();
            state_update(lds, acc_s, gc, w, c, q);
            __syncthreads();
        }
        GS[((size_t)(uid * 8 + w) * 2 + 0) * 64 + lane] = acc_s[0];
        GS[((size_t)(uid * 8 + w) * 2 + 1) * 64 + lane] = acc_s[1];
    }
}
__device__ __forceinline__ void phase_b(unsigned char* lds_, const unsigned short* PROJ, const f32x4* GS, const float* gs, unsigned short* Y, int grid, int block) {
    ldsptr lds = (ldsptr)lds_;
    int tid_l = threadIdx.x; asm volatile("" : "+v"(tid_l));
    const int tid = tid_l, lane = tid & 63, w = __builtin_amdgcn_readfirstlane(tid >> 6), c = lane & 15, q = lane >> 4;
    for (int uid = block; uid < 512; uid += grid) {
        const int bh = uid >> 3, g = uid & 7, b = bh >> 3, h = bh & 7;
        const float l2g = head_l2g(h), gc = exp2f(128.0f * l2g);
        const unsigned short* Pb = PROJ + (size_t)b * SEQL * NINP;
        f32x4 acc_s[2] = {(f32x4){0.f, 0.f, 0.f, 0.f}, (f32x4){0.f, 0.f, 0.f, 0.f}};
        for (int gp = 0; gp < g; ++gp) {
            const float wgt = exp2f(512.0f * (float)(g - 1 - gp) * l2g);
            const size_t base = ((size_t)((bh * 8 + gp) * 8 + w) * 2) * 64 + lane;
            acc_s[0] += GS[base] * wgt; acc_s[1] += GS[base + 64] * wgt;
        }
        const int dt = w >> 1, et0 = 2 * (w & 1);
        float gr[4];
#pragma unroll
        for (int r = 0; r < 4; ++r) gr[r] = exp2f(-(float)r * l2g);
        for (int i = 0; i < 4; ++i) {
            const int row0 = (4 * g + i) * 128;
#pragma unroll
            for (int t2 = 0; t2 < 2; ++t2) { u32x2 v; v.x = pk2_(acc_s[t2][0], acc_s[t2][1]); v.y = pk2_(acc_s[t2][2], acc_s[t2][3]);
                *(RLAS u32x2*)(lds + OFF_RT + ((16 * (et0 + t2) + c) * RS + 16 * dt + 4 * q) * 2) = v; }
            stage<true>(lds, Pb, row0, h, l2g, tid);
            __syncthreads();
            const int il = 16 * w + c;
            for (int jb = 0; jb <= w; ++jb) {
                f32x4 s = {0.f, 0.f, 0.f, 0.f};
#pragma unroll
                for (int ks = 0; ks < 2; ++ks) s = MFMA16(ldA(lds + OFF_K, 16 * jb + c, 32 * ks + 8 * q, RS), ldA(lds + OFF_Q, il, 32 * ks + 8 * q, RS), s);
                const int dj = il - 16 * jb - 4 * q;
                const float e0 = __builtin_amdgcn_exp2f((float)dj * l2g);
                float pv[4];
#pragma unroll
                for (int r = 0; r < 4; ++r) pv[r] = (dj - r >= 0) ? s[r] * e0 * gr[r] : 0.f;
                u32x2 v; v.x = pk2_(pv[0], pv[1]); v.y = pk2_(pv[2], pv[3]);
                *(RLAS u32x2*)(lds + OFF_P + (il * PS + 16 * jb + 4 * q) * 2) = v;
            }
            if ((w & 1) == 0) *(RLAS u32x2*)(lds + OFF_P + (il * PS + 16 * (w + 1) + 4 * q) * 2) = (u32x2){0u, 0u};
            f32x4 a1[4], a2[4];
#pragma unroll
            for (int et = 0; et < 4; ++et) { a1[et] = (f32x4){0.f, 0.f, 0.f, 0.f}; a2[et] = (f32x4){0.f, 0.f, 0.f, 0.f}; }
            const int nks = (w >> 1) + 1;
            for (int ks = 0; ks < nks; ++ks) {
                const bf16x8 ap = ldA(lds + OFF_P, il, 32 * ks + 8 * q, PS);
#pragma unroll
                for (int et = 0; et < 4; ++et) a1[et] = MFMA16(ap, ldT(lds + OFF_V, 32 * ks, 16 * et, c, q), a1[et]);
            }
#pragma unroll
            for (int ks = 0; ks < 2; ++ks) {
                const bf16x8 aq = ldA(lds + OFF_Q, il, 32 * ks + 8 * q, RS);
#pragma unroll
                for (int et = 0; et < 4; ++et) a2[et] = MFMA16(aq, ldA(lds + OFF_RT, 16 * et + c, 32 * ks + 8 * q, RS), a2[et]);
            }
            float xi[4], sum[4], mu[4], rs[4];
#pragma unroll
            for (int r = 0; r < 4; ++r) { xi[r] = __builtin_amdgcn_exp2f((float)(16 * w + 4 * q + r + 1) * l2g); sum[r] = 0.f; }
#pragma unroll
            for (int et = 0; et < 4; ++et)
#pragma unroll
                for (int r = 0; r < 4; ++r) { a1[et][r] += xi[r] * a2[et][r]; sum[r] += a1[et][r]; }
#pragma unroll
            for (int r = 0; r < 4; ++r) { float s = sum[r]; s += __shfl_xor(s, 1); s += __shfl_xor(s, 2); s += __shfl_xor(s, 4); s += __shfl_xor(s, 8); mu[r] = s * (1.f / 64.f); sum[r] = 0.f; }
#pragma unroll
            for (int et = 0; et < 4; ++et)
#pragma unroll
                for (int r = 0; r < 4; ++r) { const float d = a1[et][r] - mu[r]; a1[et][r] = d; sum[r] += d * d; }
#pragma unroll
            for (int r = 0; r < 4; ++r) { float s = sum[r]; s += __shfl_xor(s, 1); s += __shfl_xor(s, 2); s += __shfl_xor(s, 4); s += __shfl_xor(s, 8); rs[r] = 1.0f / sqrtf(s * (1.f / 64.f) + 1e-6f); }
#pragma unroll
            for (int et = 0; et < 4; ++et) {
                const int e = 16 * et + c; const float gse = gs[h * 64 + e];
#pragma unroll
                for (int r = 0; r < 4; ++r) {
                    const size_t row = (size_t)b * SEQL + row0 + 16 * w + 4 * q + r;
                    const float gate = bf2f_(PROJ[row * NINP + 1536 + h * 64 + e]);
                    Y[row * 1024 + h * 64 + e] = (unsigned short)f2bf_(a1[et][r] * rs[r] * gate * gse);
                }
            }
            state_update(lds, acc_s, gc, w, c, q);
            __syncthreads();
        }
    }
}
#undef MFMA16
#undef RLAS
}
#define LAS __attribute__((address_space(3)))
#define XB_TMO      128
#define XB_XCNT(j)  (256  + 64 * (j))
#define XB_XSUB(j)  (1280 + 64 * (j))
#define XB_XGEN(j)  (2304 + 64 * (j))
#define XB_TOP      3328
#define XB_TOPGEN   3392
#define XCD_BAR_WORDS 3456
#define XB_SPIN_CAP (1u << 18)

__device__ __forceinline__ unsigned xb_ld(unsigned* p)              { return __hip_atomic_load(p, __ATOMIC_RELAXED, __HIP_MEMORY_SCOPE_AGENT); }
__device__ __forceinline__ unsigned xb_add(unsigned* p, unsigned v) { return __hip_atomic_fetch_add(p, v, __ATOMIC_RELAXED, __HIP_MEMORY_SCOPE_AGENT); }
__device__ __forceinline__ unsigned xb_xcc_id() { return (unsigned)__builtin_amdgcn_s_getreg((3 << 11) | 20) & 0xFu; }
#define XB_SPIN(cond, bar) do { unsigned _sp = 0; while (cond) { __builtin_amdgcn_s_sleep(1); \
    if ((++_sp & 255u) == 0u) { if (xb_ld(&(bar)[XB_TMO])) break; if (_sp > XB_SPIN_CAP) { atomicAdd(&(bar)[XB_TMO], 1u); break; } } } } while (0)

struct XcdBarrier {
    unsigned* bar; unsigned x;
    volatile LAS unsigned* st;
};

__device__ __forceinline__ XcdBarrier xcd_barrier_post(unsigned* bar, volatile LAS unsigned* st) {
    XcdBarrier b; b.bar = bar; b.x = xb_xcc_id(); b.st = st;
    if (threadIdx.x == 0) (void)xb_add(&bar[XB_XCNT(b.x)], 1u);
    return b;
}
__device__ __forceinline__ void xcd_barrier_complete(unsigned* bar, unsigned x, unsigned& nloc, unsigned& nx) {
    const unsigned G = gridDim.x * gridDim.y * gridDim.z;
    unsigned sum, cnt, mine, sp = 0u;
    for (;;) {
        sum = 0u; cnt = 0u; mine = 0u;
#pragma unroll
        for (unsigned j = 0; j < 16; ++j) { const unsigned c = xb_ld(&bar[XB_XCNT(j)]); sum += c; cnt += (c > 0u) ? 1u : 0u; mine = (j == x) ? c : mine; }
        if (sum == G) break;
        __builtin_amdgcn_s_sleep(1);
        if ((++sp & 255u) == 0u) { if (xb_ld(&bar[XB_TMO])) break; if (sp > XB_SPIN_CAP) { atomicAdd(&bar[XB_TMO], 1u); break; } }
    }
    nloc = mine > 0u ? mine : 1u; nx = cnt > 0u ? cnt : 1u;
}

__device__ __forceinline__ void xcd_barrier(const XcdBarrier& b) {
    asm volatile("s_waitcnt vmcnt(0)" ::: "memory");
    __syncthreads();
    if (threadIdx.x == 0) {
        unsigned* bar = b.bar;
        __builtin_amdgcn_s_waitcnt(0);
        unsigned nloc = b.st[0], nx = b.st[1];
        if (nloc == 0u) { xcd_barrier_complete(bar, b.x, nloc, nx); b.st[0] = nloc; b.st[1] = nx; }
        const unsigned old = xb_add(&bar[XB_XSUB(b.x)], 1u);
        const unsigned gen = old / nloc;
        if (old + 1u == (gen + 1u) * nloc) {
            __builtin_amdgcn_fence(__ATOMIC_RELEASE, "agent");
            asm volatile("s_waitcnt vmcnt(0)" ::: "memory");
            const unsigned og = xb_add(&bar[XB_TOP], 1u);
            const unsigned tg = og / nx;
            if (og + 1u == (tg + 1u) * nx) xb_add(&bar[XB_TOPGEN], 1u);
            else XB_SPIN(xb_ld(&bar[XB_TOPGEN]) == tg, bar);
            __builtin_amdgcn_fence(__ATOMIC_ACQUIRE, "agent");
            xb_add(&bar[XB_XGEN(b.x)], 1u);
            asm volatile("s_waitcnt vmcnt(0)" ::: "memory");
        } else {
            XB_SPIN(xb_ld(&bar[XB_XGEN(b.x)]) == gen, bar);
            __builtin_amdgcn_fence(__ATOMIC_ACQUIRE, "agent");
            asm volatile("s_waitcnt vmcnt(0)" ::: "memory");
        }
    }
    __syncthreads();
}
typedef unsigned short bf16;
typedef float f32x4 __attribute__((ext_vector_type(4)));
typedef unsigned u32x4 __attribute__((ext_vector_type(4)));
typedef unsigned u32x2 __attribute__((ext_vector_type(2)));

__device__ __forceinline__ unsigned f2bf(float f) { unsigned u = __builtin_bit_cast(unsigned, f); return (u + 0x7fffu + ((u >> 16) & 1u)) >> 16; }
__device__ __forceinline__ float bf2f(unsigned h) { return __builtin_bit_cast(float, h << 16); }
__device__ __forceinline__ unsigned pk2(float lo, float hi) { return f2bf(lo) | (f2bf(hi) << 16); }
__device__ __forceinline__ float silu_f(float v) { return v / (1.f + expf(-v)); }
__device__ __forceinline__ float wave_sum(float v) {
#pragma unroll
    for (int o = 1; o < 64; o <<= 1) v += __shfl_xor(v, o);
    return v;
}
__device__ __forceinline__ void unpack8(u32x4 v, float (&a)[8]) {
    a[0] = bf2f(v.x & 0xffffu); a[1] = bf2f(v.x >> 16); a[2] = bf2f(v.y & 0xffffu); a[3] = bf2f(v.y >> 16);
    a[4] = bf2f(v.z & 0xffffu); a[5] = bf2f(v.z >> 16); a[6] = bf2f(v.w & 0xffffu); a[7] = bf2f(v.w >> 16);
}

constexpr size_t MiB = 1u << 20;
constexpr size_t WS_CTL = 0, CTL_ZERO_BYTES = 65536;
constexpr size_t WS_MOD = 1 * MiB;
constexpr size_t WS_BIAS = 1 * MiB + 512 * 1024;
constexpr size_t WS_ROPE = 2 * MiB;
constexpr size_t WS_TAB = 3 * MiB;
constexpr size_t WS_SS = 3 * MiB + 65536;
constexpr size_t WS_W1T = 4 * MiB;
constexpr size_t WS_W2T = 15 * MiB;
constexpr size_t WS_WINT = 21 * MiB;
constexpr size_t WS_WOT = 28 * MiB;
constexpr size_t WS_W3T = 30 * MiB;
constexpr size_t WS_W4T = 41 * MiB;
constexpr size_t WS_GS = 48 * MiB;
constexpr size_t WS_H = 96 * MiB;
constexpr size_t WS_OA = 160 * MiB;
constexpr size_t WS_ACT = 224 * MiB;
constexpr size_t WS_PROJ = WS_ACT;
constexpr size_t WS_Y = 448 * MiB;
constexpr size_t WS_END = 512 * MiB;

struct Params { const float* in[21]; float* out; unsigned char* ws; };
enum { I_X = 0, I_C, I_WADA, I_BADA, I_NF1, I_W1IN, I_W1OUT, I_NMIX, I_WIN, I_LQ1, I_LK1, I_LQ2, I_LK2, I_SUBLN, I_GS, I_WOUT, I_NF2, I_W2IN, I_W2OUT, I_RELB, I_NFIN };

constexpr int NTHREADS = 512, NWAVES = 8;
constexpr int LDS_BYTES = 147456;
constexpr int LDS_MISC_OFF = 131072 + 320;

template <int MAP> __device__ __forceinline__ int physrow32(int n0) {
    if (MAP == 1) { return n0 < FF ? 256 * (n0 / 128) + (n0 % 128) : 256 * ((n0 - FF) / 128) + 128 + ((n0 - FF) % 128); }
    if (MAP == 2) { if (n0 < 1024) { const int pn = n0 >> 8, w = n0 & 255, head = w >> 6, half = (w >> 5) & 1; return 256 * pn + half * 128 + head * 32; } return n0; }
    return n0;
}
template <int MAP> __device__ __forceinline__ void transpose_item(const float* W, int K, int N, bf16* WT, LAS float* scr, int item, int lane) {
    const int nblk = N / 32, kb = item / nblk, nb = item % nblk, k0 = 64 * kb, n0 = 32 * nb;
#pragma unroll 8
    for (int i = 0; i < 32; ++i) { const int kk = 2 * i + (lane >> 5); scr[kk * 33 + (lane & 31)] = W[(size_t)(k0 + kk) * N + n0 + (lane & 31)]; }
    asm volatile("s_waitcnt lgkmcnt(0)" ::: "memory");
    const int c = lane & 7; const int prow = physrow32<MAP>(n0);
#pragma unroll
    for (int j = 0; j < 4; ++j) { const int n = (lane >> 3) + 8 * j; const LAS float* s = scr + (8 * c) * 33 + n;
        u32x4 o; o.x = pk2(s[0 * 33], s[1 * 33]); o.y = pk2(s[2 * 33], s[3 * 33]); o.z = pk2(s[4 * 33], s[5 * 33]); o.w = pk2(s[6 * 33], s[7 * 33]);
        *(u32x4*)(WT + (size_t)(prow + n) * K + k0 + 8 * c) = o; }
    asm volatile("s_waitcnt lgkmcnt(0)" ::: "memory");
}

__device__ __forceinline__ void norm_rows(const float* X, const float* g, const float* mod, int shi, int sci, bf16* H, long gwave, long nwaves, int lane) {
    for (long row = gwave; row < T; row += nwaves) {
        const int b = (int)(row / SEQ);
        const f32x4* xr = (const f32x4*)(X + (size_t)row * DM) + lane;
        f32x4 v[4]; float ss = 0.f;
#pragma unroll
        for (int j = 0; j < 4; ++j) { v[j] = xr[64 * j]; ss += (v[j].x * v[j].x + v[j].y * v[j].y) + (v[j].z * v[j].z + v[j].w * v[j].w); }
        const float rinv = 1.0f / sqrtf(wave_sum(ss) * (1.f / DM) + EPS);
        u32x2* o = (u32x2*)(H + (size_t)row * DM) + lane;
#pragma unroll
        for (int j = 0; j < 4; ++j) {
            const int col = 256 * j + 4 * lane;
            const f32x4 gg = *(const f32x4*)(g + col);
            const f32x4 sc = *(const f32x4*)(mod + (size_t)b * NMODC + sci * DM + col);
            const f32x4 sh = *(const f32x4*)(mod + (size_t)b * NMODC + shi * DM + col);
            f32x4 r = v[j] * rinv * gg * (sc + 1.0f) + sh;
            u32x2 w; w.x = pk2(r.x, r.y); w.y = pk2(r.z, r.w); o[64 * j] = w;
        }
    }
}

__device__ __forceinline__ int t5_bucket(int n) {
    if (n < 16) return n;
    if (n >= 113) return 31;
    int large = 16 + (int)(logf((float)n / 16.0f) / 2.0794415416798357f * 16.0f);
    return large < 31 ? large : 31;
}

__device__ __forceinline__ void retention_simple(const bf16* PROJ, const float* gs, bf16* Y, long gtid, long gthreads) {
    for (long it = gtid; it < (long)BATCH * 8 * SEQ; it += gthreads) {
        const int i = (int)(it % SEQ), h = (int)((it / SEQ) % 8), b = (int)(it / (SEQ * 8));
        const float l2g = log2f(1.0f - exp2f(-5.0f - (float)h));
        const bf16* base = PROJ + (size_t)b * SEQ * NIN;
        float q[64], o[64];
#pragma unroll
        for (int d8 = 0; d8 < 8; ++d8) { float a[8]; unpack8(*(const u32x4*)(base + (size_t)i * NIN + h * 64 + d8 * 8), a);
#pragma unroll
            for (int j = 0; j < 8; ++j) q[d8 * 8 + j] = a[j]; }
#pragma unroll
        for (int e = 0; e < 64; ++e) o[e] = 0.f;
        for (int t = 0; t <= i; ++t) {
            const bf16* kr = base + (size_t)t * NIN + 512 + h * 64; const bf16* vr = base + (size_t)t * NIN + 1024 + h * 64;
            float s = 0.f;
#pragma unroll
            for (int d8 = 0; d8 < 8; ++d8) { float a[8]; unpack8(*(const u32x4*)(kr + d8 * 8), a);
#pragma unroll
                for (int j = 0; j < 8; ++j) s += q[d8 * 8 + j] * a[j]; }
            s *= exp2f((float)(i - t) * l2g);
#pragma unroll
            for (int d8 = 0; d8 < 8; ++d8) { float a[8]; unpack8(*(const u32x4*)(vr + d8 * 8), a);
#pragma unroll
                for (int j = 0; j < 8; ++j) o[d8 * 8 + j] += s * a[j]; }
        }
        float mu = 0.f;
#pragma unroll
        for (int e = 0; e < 64; ++e) mu += o[e];
        mu *= (1.f / 64.f); float var = 0.f;
#pragma unroll
        for (int e = 0; e < 64; ++e) { const float d = o[e] - mu; var += d * d; }
        const float rs = 1.0f / sqrtf(var * (1.f / 64.f) + EPS);
        const size_t row = (size_t)b * SEQ + i;
#pragma unroll
        for (int e = 0; e < 64; ++e) {
            const float g = bf2f(PROJ[row * NIN + 1536 + h * 64 + e]);
            Y[row * DM + h * 64 + e] = (bf16)f2bf((o[e] - mu) * rs * g * gs[h * 64 + e]);
        }
    }
}
__device__ __forceinline__ void diffattn_simple(const bf16* PROJ, const float* relb, bf16* OA, long gtid, long gthreads) {
    for (long it = gtid; it < (long)BATCH * 32 * SEQ; it += gthreads) {
        const int qi = (int)(it % SEQ); const int rest = (int)(it / SEQ);
        const int vq = rest & 3, m = (rest >> 2) & 1, h = (rest >> 3) & 3, b = rest >> 5;
        const bf16* base = PROJ + (size_t)b * SEQ * NIN;
        float q[64], o[32];
#pragma unroll
        for (int d8 = 0; d8 < 8; ++d8) { float a[8]; unpack8(*(const u32x4*)(base + (size_t)qi * NIN + 2048 + h * 128 + m * 64 + d8 * 8), a);
#pragma unroll
            for (int j = 0; j < 8; ++j) q[d8 * 8 + j] = a[j]; }
#pragma unroll
        for (int e = 0; e < 32; ++e) o[e] = 0.f;
        float mrun = -1e30f, l = 0.f;
        for (int t = 0; t <= qi; ++t) {
            const bf16* kr = base + (size_t)t * NIN + 2560 + h * 128 + m * 64; const bf16* vr = base + (size_t)t * NIN + 3072 + h * 128 + vq * 32;
            float s = 0.f;
#pragma unroll
            for (int d8 = 0; d8 < 8; ++d8) { float a[8]; unpack8(*(const u32x4*)(kr + d8 * 8), a);
#pragma unroll
                for (int j = 0; j < 8; ++j) s += q[d8 * 8 + j] * a[j]; }
            s += relb[t5_bucket(qi - t) * 4 + h] * LOG2E;
            if (s > mrun) { const float f = exp2f(mrun - s); l *= f;
#pragma unroll
                for (int e = 0; e < 32; ++e) o[e] *= f;
                mrun = s; }
            const float pe = exp2f(s - mrun); l += pe;
#pragma unroll
            for (int d8 = 0; d8 < 4; ++d8) { float a[8]; unpack8(*(const u32x4*)(vr + d8 * 8), a);
#pragma unroll
                for (int j = 0; j < 8; ++j) o[d8 * 8 + j] += pe * a[j]; }
        }
        const float li = 1.0f / l; const size_t row = (size_t)b * SEQ + qi;
        bf16* op = OA + row * DM + ((h * 2 + m) * 2 + (vq >> 1)) * 64 + (vq & 1) * 32;
#pragma unroll
        for (int e = 0; e < 32; ++e) op[e] = (bf16)f2bf(o[e] * li);
    }
}
__device__ __forceinline__ void combine_rows(const Params& p, const bf16* OA, bf16* Y, long gwave, long nwaves, int lane) {
    const float s1 = wave_sum(p.in[I_LQ1][lane] * p.in[I_LK1][lane]), s2 = wave_sum(p.in[I_LQ2][lane] * p.in[I_LK2][lane]);
    const float lam = expf(s1) - expf(s2) + 0.2f;
    const int h = lane >> 4, e0 = (lane & 15) * 8, half = e0 >> 6, ee = e0 & 63;
    for (long row = gwave; row < T; row += nwaves) {
        float a0[8], a1[8], d[8];
        unpack8(*(const u32x4*)(OA + (size_t)row * DM + ((h * 2 + 0) * 2 + half) * 64 + ee), a0);
        unpack8(*(const u32x4*)(OA + (size_t)row * DM + ((h * 2 + 1) * 2 + half) * 64 + ee), a1);
        float ss = 0.f;
#pragma unroll
        for (int j = 0; j < 8; ++j) { d[j] = a0[j] - lam * a1[j]; ss += d[j] * d[j]; }
        ss += __shfl_xor(ss, 1); ss += __shfl_xor(ss, 2); ss += __shfl_xor(ss, 4); ss += __shfl_xor(ss, 8);
        const float rs = 1.0f / sqrtf(ss * (1.f / 128.f) + EPS);
        unsigned w[4];
#pragma unroll
        for (int j = 0; j < 8; j += 2) {
            const float y0 = d[j] * rs * p.in[I_SUBLN][e0 + j] * 0.8f * p.in[I_GS][512 + h * 128 + e0 + j];
            const float y1 = d[j + 1] * rs * p.in[I_SUBLN][e0 + j + 1] * 0.8f * p.in[I_GS][512 + h * 128 + e0 + j + 1];
            w[j >> 1] = pk2(y0, y1);
        }
        *(u32x4*)(Y + (size_t)row * DM + 512 + h * 128 + e0) = (u32x4){w[0], w[1], w[2], w[3]};
    }
}

__device__ __forceinline__ void bias_rows(const bf16* WT, int nrows, const float* mod, int shi, float* BIAS, long gwave, long nwaves, int lane) {
    float sh[8][16];
#pragma unroll
    for (int b = 0; b < 8; ++b)
#pragma unroll
        for (int j = 0; j < 2; ++j) { const float* sp = mod + (size_t)b * NMODC + shi * DM + j * 512 + 8 * lane; const f32x4 a = *(const f32x4*)sp, c = *(const f32x4*)(sp + 4);
            sh[b][8 * j + 0] = a.x; sh[b][8 * j + 1] = a.y; sh[b][8 * j + 2] = a.z; sh[b][8 * j + 3] = a.w; sh[b][8 * j + 4] = c.x; sh[b][8 * j + 5] = c.y; sh[b][8 * j + 6] = c.z; sh[b][8 * j + 7] = c.w; }
    for (long r = gwave; r < nrows; r += nwaves) {
        float w0[8], w1[8];
        unpack8(*(const u32x4*)(WT + (size_t)r * DM + 8 * lane), w0); unpack8(*(const u32x4*)(WT + (size_t)r * DM + 512 + 8 * lane), w1);
#pragma unroll
        for (int b = 0; b < 8; ++b) { float s = 0.f;
#pragma unroll
            for (int j = 0; j < 8; ++j) s += sh[b][j] * w0[j] + sh[b][8 + j] * w1[j];
            s = wave_sum(s); if (lane == b) BIAS[(size_t)b * nrows + r] = s; }
    }
}

#if defined(PROBE_A)
#define SEAM(k) do { if (blockIdx.x == 0 && threadIdx.x == 0) { ((volatile LAS unsigned long long*)(ldsp + 131072 + 1024))[k] = __builtin_amdgcn_s_memrealtime(); \
        if ((k) == 10) { volatile LAS unsigned long long* ts_ = (volatile LAS unsigned long long*)(ldsp + 131072 + 1024); \
            const float ua = (float)(ts_[PROBE_A + 1] - ts_[PROBE_A]) * 0.01f, ub = (float)(ts_[PROBE_B + 1] - ts_[PROBE_B]) * 0.01f; \
            ((float*)(ws + WS_TAB))[1024] = sqrtf(ua * 1e-6f); ((float*)(ws + WS_TAB))[1025] = 0.0f * ub; } } \
    xcd_barrier(bar); } while (0)
#else
#define SEAM(k) xcd_barrier(bar)
#endif
__global__ void __launch_bounds__(NTHREADS, 2) fwd_mega(Params p) {
    extern __shared__ __attribute__((aligned(16))) unsigned char lds[];
#define PHASE_IDS int tid_l = threadIdx.x; asm volatile("" : "+v"(tid_l)); const int tid = tid_l, lane = tid & 63, wave = __builtin_amdgcn_readfirstlane(tid >> 6); \
    const long gtid = (long)blockIdx.x * NTHREADS + tid, gthreads = (long)gridDim.x * NTHREADS; \
    const long gwave = (long)blockIdx.x * NWAVES + wave, nwaves = (long)gridDim.x * NWAVES; (void)lane; (void)gtid; (void)gthreads; (void)gwave; (void)nwaves;
    unsigned char* ws = p.ws;
    float* MOD = (float*)(ws + WS_MOD);
    float* ROPEC = (float*)(ws + WS_ROPE); float* ROPES = ROPEC + SEQ * 32;
    float* TAB = (float*)(ws + WS_TAB); float* CFAR = TAB + 4 * 128;
    float* SSM = (float*)(ws + WS_SS); float* SS2 = SSM + T; float* BIASM = (float*)(ws + WS_BIAS); float* BIAS2 = BIASM + 8 * NIN;
    bf16* H = (bf16*)(ws + WS_H); bf16* Y = (bf16*)(ws + WS_Y); bf16* OA = (bf16*)(ws + WS_OA);
    bf16* ACT = (bf16*)(ws + WS_ACT); bf16* PROJ = (bf16*)(ws + WS_PROJ);
    bf16 *W1T = (bf16*)(ws + WS_W1T), *W2T = (bf16*)(ws + WS_W2T), *WINT = (bf16*)(ws + WS_WINT), *WOT = (bf16*)(ws + WS_WOT), *W3T = (bf16*)(ws + WS_W3T), *W4T = (bf16*)(ws + WS_W4T);
    const float* x = p.in[I_X]; float* X = p.out;
    PG8_LAS unsigned char* ldsp = (PG8_LAS unsigned char*)lds;
    for (int u = threadIdx.x; u < (LDS_BYTES - 131072) / 4; u += NTHREADS) ((LAS unsigned*)(ldsp + 131072))[u] = 0u;
    __syncthreads();
#if defined(PROBE_A)
    if (blockIdx.x == 0 && threadIdx.x == 0) ((volatile LAS unsigned long long*)(ldsp + 131072 + 1024))[0] = __builtin_amdgcn_s_memrealtime();
#endif
    const XcdBarrier bar = xcd_barrier_post((unsigned*)(ws + WS_CTL) + 1024, (volatile LAS unsigned*)(ldsp + LDS_MISC_OFF) + 8);

    {
        PHASE_IDS
        float* sc = (float*)lds;
        float* red = sc + 8 * DM;
        if (blockIdx.x < NMODC / 64) {
            for (int i = tid; i < 8 * DM; i += NTHREADS) sc[i] = silu_f(p.in[I_C][i]);
            __syncthreads();
            const int kg = tid >> 6, cg_ = tid & 63; constexpr int klen = DM / 8;
            for (int item = blockIdx.x; item < NMODC / 64; item += gridDim.x) {
                const int n = item * 64 + cg_;
                float acc[8];
#pragma unroll
                for (int b = 0; b < 8; ++b) acc[b] = 0.f;
                const float* w = p.in[I_WADA] + (size_t)(kg * klen) * NMODC + n;
#pragma unroll 4
                for (int k = 0; k < klen; ++k) {
                    const float wv = w[(size_t)k * NMODC];
#pragma unroll
                    for (int b = 0; b < 8; ++b) acc[b] += sc[b * DM + kg * klen + k] * wv;
                }
#pragma unroll
                for (int b = 0; b < 8; ++b) red[(kg * 8 + b) * 64 + cg_] = acc[b];
                __syncthreads();
                { const int b = tid >> 6, c = tid & 63; float s = 0.f;
#pragma unroll
                  for (int g2 = 0; g2 < 8; ++g2) s += red[(g2 * 8 + b) * 64 + c];
                  MOD[(size_t)b * NMODC + item * 64 + c] = s + p.in[I_BADA][item * 64 + c]; }
                __syncthreads();
            }
        }
        for (long i = gtid; i < 2L * T; i += gthreads) SSM[i] = 0.f;
        for (long i = gtid; i < (long)SEQ * 32; i += gthreads) {
            const int pos = (int)(i >> 5), j = (int)(i & 31);
            const float inv = powf(10000.0f, -(float)(2 * j) / 64.0f);
            const float ang = (float)pos * inv;
            ROPEC[i] = cosf(ang); ROPES[i] = sinf(ang);
        }
        if (blockIdx.x == gridDim.x - 1) {
            const int h = tid >> 7, n = tid & 127; const float far = p.in[I_RELB][31 * 4 + h];
            TAB[h * 128 + n] = (p.in[I_RELB][t5_bucket(n) * 4 + h] - far) * LOG2E;
            if (tid < 4) CFAR[tid] = p.in[I_RELB][31 * 4 + tid] * LOG2E;
        }
        __syncthreads();
        LAS float* scr = (LAS float*)(ldsp + wave * 16384);
        constexpr int I_A = (DM / 64) * (2 * FF / 32), I_B = (FF / 64) * (DM / 32), I_C2 = (DM / 64) * (NIN / 32), I_D = (DM / 64) * (DM / 32);
        constexpr int NITEMS = 2 * I_A + 2 * I_B + I_C2 + I_D;
        for (int it = (int)gwave; it < NITEMS; it += (int)nwaves) {
            int r = it;
            if (r < I_A) { transpose_item<1>(p.in[I_W1IN], DM, 2 * FF, W1T, scr, r, lane); continue; } r -= I_A;
            if (r < I_A) { transpose_item<1>(p.in[I_W2IN], DM, 2 * FF, W3T, scr, r, lane); continue; } r -= I_A;
            if (r < I_B) { transpose_item<0>(p.in[I_W1OUT], FF, DM, W2T, scr, r, lane); continue; } r -= I_B;
            if (r < I_B) { transpose_item<0>(p.in[I_W2OUT], FF, DM, W4T, scr, r, lane); continue; } r -= I_B;
            if (r < I_C2) { transpose_item<2>(p.in[I_WIN], DM, NIN, WINT, scr, r, lane); continue; } r -= I_C2;
            transpose_item<0>(p.in[I_WOUT], DM, DM, WOT, scr, r, lane);
        }
    }
    SEAM(1);
    { PHASE_IDS norm_rows(x, p.in[I_NF1], MOD, 0, 1, H, gwave, nwaves, lane); }
    { PHASE_IDS bias_rows(WINT, NIN, MOD, 3, BIASM, gwave, nwaves, lane); }
    { PHASE_IDS bias_rows(W3T, 2 * FF, MOD, 6, BIAS2, gwave, nwaves, lane); }
    SEAM(2);
    { pg8::Gemm g{H, W1T, T, 2 * FF, DM}; pg8::StaticOrder S; S.init(T, 2 * FF, (int)gridDim.x, (int)blockIdx.x); pg8::EpiSwiglu<false> E{ACT, FF, nullptr, nullptr};
      pg8::gemm_phase<pg8::EpiSwiglu<false>, pg8::StaticOrder, true, true>(ldsp, g, S, E); }
    SEAM(3);
    { pg8::Gemm g{ACT, W2T, T, DM, FF}; pg8::StaticOrder S; S.init(T, DM, (int)gridDim.x, (int)blockIdx.x); pg8::EpiResid<true> E{x, X, MOD + 2 * DM, p.in[I_NMIX], MOD + 4 * DM, H, SSM, 0.5f};
      pg8::gemm_phase<pg8::EpiResid<true>, pg8::StaticOrder, true, true>(ldsp, g, S, E); }
    SEAM(4);
    { pg8::Gemm g{H, WINT, T, NIN, DM}; pg8::StaticOrder S; S.init(T, NIN, (int)gridDim.x, (int)blockIdx.x); pg8::EpiProj E{PROJ, ROPEC, ROPES, C2, SSM, BIASM};
      pg8::gemm_phase<pg8::EpiProj, pg8::StaticOrder, true, true>(ldsp, g, S, E); }
    SEAM(5);
    attn_body::attn_phase<8>((char*)lds, (const attn_body::bf16*)PROJ, (attn_body::bf16*)OA, TAB, CFAR, (int)gridDim.x, (int)blockIdx.x);
    ret::phase_a(lds, PROJ, (ret::f32x4*)(ws + WS_GS), (int)gridDim.x, (int)blockIdx.x);
    SEAM(6);
    ret::phase_b(lds, PROJ, (const ret::f32x4*)(ws + WS_GS), p.in[I_GS], Y, (int)gridDim.x, (int)blockIdx.x);
    { PHASE_IDS combine_rows(p, OA, Y, gwave, nwaves, lane); }
    SEAM(7);
    { pg8::Gemm g{Y, WOT, T, DM, DM}; pg8::StaticOrder S; S.init(T, DM, (int)gridDim.x, (int)blockIdx.x); pg8::EpiResid<true> E{X, X, MOD + 5 * DM, p.in[I_NF2], MOD + 7 * DM, H, SS2, 1.0f};
      pg8::gemm_phase<pg8::EpiResid<true>, pg8::StaticOrder, true, true>(ldsp, g, S, E); }
    SEAM(8);
    { pg8::Gemm g{H, W3T, T, 2 * FF, DM}; pg8::StaticOrder S; S.init(T, 2 * FF, (int)gridDim.x, (int)blockIdx.x); pg8::EpiSwiglu<true> E{ACT, FF, SS2, BIAS2};
      pg8::gemm_phase<pg8::EpiSwiglu<true>, pg8::StaticOrder, true, true>(ldsp, g, S, E); }
    SEAM(9);
    { pg8::Gemm g{ACT, W4T, T, DM, FF}; pg8::StaticOrder S; S.init(T, DM, (int)gridDim.x, (int)blockIdx.x); pg8::EpiResid<false> E{X, X, MOD + 8 * DM, nullptr, nullptr, nullptr, nullptr, 0.5f};
      pg8::gemm_phase<pg8::EpiResid<false>, pg8::StaticOrder, true, true>(ldsp, g, S, E); }
    SEAM(10);
    { PHASE_IDS
    for (long row = gwave; row < T; row += nwaves) {
        f32x4* xr = (f32x4*)(X + (size_t)row * DM) + lane;
        f32x4 v[4]; float ss = 0.f;
#pragma unroll
        for (int j = 0; j < 4; ++j) { v[j] = xr[64 * j]; ss += (v[j].x * v[j].x + v[j].y * v[j].y) + (v[j].z * v[j].z + v[j].w * v[j].w); }
        const float rinv = 1.0f / sqrtf(wave_sum(ss) * (1.f / DM) + EPS);
#if defined(PROBE_A)
        const float pscale = 1.0f + ((const float*)(ws + WS_TAB))[1024];
#pragma unroll
        for (int j = 0; j < 4; ++j) { f32x4 o = v[j] * rinv * *(const f32x4*)(p.in[I_NFIN] + 256 * j + 4 * lane) * pscale; if (row == 0 && j == 0 && lane == 0) o.x += ((const float*)(ws + WS_TAB))[1025]; xr[64 * j] = o; }
#else
#pragma unroll
        for (int j = 0; j < 4; ++j) xr[64 * j] = v[j] * rinv * *(const f32x4*)(p.in[I_NFIN] + 256 * j + 4 * lane);
#endif
    } }
}

extern "C" void kernel_launch(void* const* d_in, const int* in_sizes, int n_in, void* d_out, int out_size, void* d_ws, size_t ws_size, hipStream_t stream) {
    static int grid = 0;
    if (grid == 0) {
        if (n_in != 21 || out_size != T * DM || ws_size < WS_END) { fprintf(stderr, "kernel_launch: unexpected shapes (n_in %d out %d ws %zu)\n", n_in, out_size, ws_size); grid = -1; return; }
        int dev = 0, cus = 0, per_cu = 0;
        if (hipGetDevice(&dev) != hipSuccess || hipDeviceGetAttribute(&cus, hipDeviceAttributeMultiprocessorCount, dev) != hipSuccess) { grid = -1; return; }
        if (hipFuncSetAttribute((const void*)fwd_mega, hipFuncAttributeMaxDynamicSharedMemorySize, LDS_BYTES) != hipSuccess) { fprintf(stderr, "kernel_launch: hipFuncSetAttribute failed\n"); grid = -1; return; }
        if (hipOccupancyMaxActiveBlocksPerMultiprocessor(&per_cu, (const void*)fwd_mega, NTHREADS, LDS_BYTES) != hipSuccess || per_cu < 1) { fprintf(stderr, "kernel_launch: occupancy query says %d blocks/CU\n", per_cu); (void)hipGetLastError(); }
        grid = cus;
        if (grid != 256) { fprintf(stderr, "kernel_launch: built for a 256-CU device, found %d CUs\n", cus); grid = -1; return; }
        fprintf(stderr, "kernel_launch: %d CUs, occupancy %d\n", cus, per_cu);
    }
    if (grid < 0) return;
    if (hipMemsetAsync((char*)d_ws + WS_CTL, 0, CTL_ZERO_BYTES, stream) != hipSuccess) { fprintf(stderr, "kernel_launch: hipMemsetAsync failed\n"); return; }
    Params p{};
    for (int i = 0; i < 21; ++i) p.in[i] = (const float*)d_in[i];
    p.out = (float*)d_out; p.ws = (unsigned char*)d_ws;
    void* args[] = {&p};
    hipError_t e = hipLaunchCooperativeKernel((const void*)fwd_mega, dim3(grid), dim3(NTHREADS), args, LDS_BYTES, stream);
    if (e != hipSuccess) fprintf(stderr, "cooperative launch failed: %s (grid %d)\n", hipGetErrorString(e), grid);
}
```

```cpp
#include <hip/hip_runtime.h>
#include <hip/hip_cooperative_groups.h>
#include <cstdio>
#include <cstdint>
namespace cg = cooperative_groups;

constexpr int BATCH = 8, SEQ = 4096, DM = 1024, T = BATCH * SEQ, FF = 2816, NIN = 3584, NMODC = 9 * DM;
constexpr float EPS = 1e-6f;
constexpr float LOG2E = 1.4426950408889634f;
constexpr float C2 = 0.125f * LOG2E;
namespace pg8 {
#define PG8_LAS __attribute__((address_space(3)))
typedef unsigned short bf16_t;
typedef short bf16x8 __attribute__((ext_vector_type(8)));
typedef float f32x4 __attribute__((ext_vector_type(4)));
typedef unsigned u32x4 __attribute__((ext_vector_type(4)));
constexpr int BM = 256, BK = 64, HALF = 128, HTB = HALF * BK * 2  , STAGE_BYTES = 8 * HTB, NXCD = 8, WGM = 8;

__host__ __device__ __forceinline__ int lds_byte(int r, int c) { const int st = (r >> 4) * 2 + (c >> 5), rr = r & 15, cc = c & 31, ob = rr * 64 + cc * 2; return st * 1024 + (ob ^ (((ob >> 9) & 1) << 5)); }
__host__ __device__ __forceinline__ void stage_rc(int b, int& R, int& C) { const int st = b / 1024, sb = b % 1024, swz = sb ^ (((sb >> 9) & 1) << 5); R = (st >> 1) * 16 + swz / 64; C = (st & 1) * 32 + (swz % 64) / 2; }
__host__ __device__ __forceinline__ int perm32(int rho) { const int n = rho >> 4, i = rho & 15; return 8 * (i >> 2) + 4 * n + (i & 3); }

struct Unit { int pm, pn; };
struct Gemm { const bf16_t* A; const bf16_t* Bt; int M, N, K; };

struct StaticOrder {
    int nM, nN, nwg, G, c;
    __host__ __device__ void init(int M, int N, int G_, int c_) { nM = M / BM; nN = N / BM; nwg = nM * nN; G = G_; c = c_; }
    __host__ __device__ bool next(int i, Unit& u) const {
        const long L = (long)i * G + c; if (L >= nwg) return false;
        int wgid = (int)L; { const int q = nwg / NXCD, r = nwg % NXCD, xcd = wgid % NXCD, off = wgid / NXCD; wgid = (xcd < r ? xcd * (q + 1) : r * (q + 1) + (xcd - r) * q) + off; }
        const int nig = WGM * nN, gid = wgid / nig, fm = gid * WGM, gsz = (nM - fm) < WGM ? (nM - fm) : WGM;
        u.pm = fm + ((wgid % nig) % gsz); u.pn = (wgid % nig) / gsz; return true;
    }
    __device__ __forceinline__ void a_ready(const Unit&) const {}
    __device__ __forceinline__ void done(const Unit&) const {}
};
__device__ __forceinline__ unsigned cvt_pk_bf16(float lo, float hi) { unsigned r; asm volatile("v_cvt_pk_bf16_f32 %0, %1, %2" : "=v"(r) : "v"(lo), "v"(hi)); return r; }
typedef float f32x2 __attribute__((ext_vector_type(2)));
__device__ __forceinline__ float fast_silu(float v) { return v * __builtin_amdgcn_rcpf(1.0f + __builtin_amdgcn_exp2f(-1.4426950408889634f * v)); }
template <bool DEFER> struct EpiSwiglu {
    static constexpr bool PERM = true, AFTER_DRAIN = false;
    bf16_t* O; int ldc; const float* ss; const float* bias;
    __device__ __forceinline__ void operator()(const f32x4 (&acc)[2][2][4][2], const Unit& u, int wr, int wc, int fr, int fq) const {
        const int row0 = u.pm * BM + wr * 64 + fr, col0 = u.pn * HALF + wc * 32 + 8 * fq;
        f32x4 bg0, bg1, bu0, bu1;
        if (DEFER) { const float* bp = bias + (size_t)(u.pm >> 4) * 5632 + u.pn * BM + wc * 32 + 8 * fq;
            bg0 = *(const f32x4*)bp; bg1 = *(const f32x4*)(bp + 4); bu0 = *(const f32x4*)(bp + HALF); bu1 = *(const f32x4*)(bp + HALF + 4); }
#pragma unroll
        for (int ai = 0; ai < 2; ++ai)
#pragma unroll
            for (int m = 0; m < 4; ++m) {
                bf16_t* rowp = O + (size_t)(row0 + ai * HALF + m * 16) * ldc + col0;
                f32x4 g0 = acc[ai][0][m][0], g1 = acc[ai][0][m][1], u0 = acc[ai][1][m][0], u1 = acc[ai][1][m][1];
                if (DEFER) { const float ri = __builtin_amdgcn_rsqf(ss[row0 + ai * HALF + m * 16] * (1.0f / 1024.0f) + 1e-6f);
                    g0 = g0 * ri + bg0; g1 = g1 * ri + bg1; u0 = u0 * ri + bu0; u1 = u1 * ri + bu1; }
                f32x4 v0, v1;
#pragma unroll
                for (int e = 0; e < 4; ++e) { v0[e] = fast_silu(g0[e]) * u0[e]; v1[e] = fast_silu(g1[e]) * u1[e]; }
                u32x4 w; w.x = cvt_pk_bf16(v0[0], v0[1]); w.y = cvt_pk_bf16(v0[2], v0[3]); w.z = cvt_pk_bf16(v1[0], v1[1]); w.w = cvt_pk_bf16(v1[2], v1[3]);
                *(u32x4*)rowp = w;
            }
    }
};
template <bool NEXT> struct EpiResid {
    static constexpr bool PERM = false, AFTER_DRAIN = false;
    const float* base; float* out; const float* gate; const float* ng; const float* nsc; bf16_t* hn; float* ssq; float scale;
    __device__ __forceinline__ void operator()(const f32x4 (&acc)[2][2][4][2], const Unit& u, int wr, int wc, int fr, int fq) const {
        const int col0 = u.pn * BM + wc * 32 + 4 * fq, b = u.pm >> 4;
        f32x4 gv[2][2], ab[2][2];
#pragma unroll
        for (int bj = 0; bj < 2; ++bj)
#pragma unroll
            for (int n = 0; n < 2; ++n) { gv[bj][n] = *(const f32x4*)(gate + (size_t)b * 9216 + col0 + bj * HALF + n * 16) * scale;
                if (NEXT) ab[bj][n] = *(const f32x4*)(ng + col0 + bj * HALF + n * 16) * (*(const f32x4*)(nsc + (size_t)b * 9216 + col0 + bj * HALF + n * 16) + 1.0f); }
#pragma unroll
        for (int ai = 0; ai < 2; ++ai)
#pragma unroll
            for (int m = 0; m < 4; ++m) {
                const int row = u.pm * BM + ai * HALF + wr * 64 + m * 16 + fr;
                const size_t off = (size_t)row * 1024 + col0; float sq = 0.f;
#pragma unroll
                for (int bj = 0; bj < 2; ++bj)
#pragma unroll
                    for (int n = 0; n < 2; ++n) { const f32x4 bs = *(const f32x4*)(base + off + bj * HALF + n * 16); const f32x4 o = bs + gv[bj][n] * acc[ai][bj][m][n]; *(f32x4*)(out + off + bj * HALF + n * 16) = o;
                        if (NEXT) { sq += (o[0] * o[0] + o[1] * o[1]) + (o[2] * o[2] + o[3] * o[3]); const f32x4 a = o * ab[bj][n];
                            typedef unsigned u32x2_t __attribute__((ext_vector_type(2))); u32x2_t w; w.x = cvt_pk_bf16(a[0], a[1]); w.y = cvt_pk_bf16(a[2], a[3]); *(u32x2_t*)(hn + off + bj * HALF + n * 16) = w; } }
                if (NEXT) { sq += __shfl_xor(sq, 16); sq += __shfl_xor(sq, 32); if (fq == 0) atomicAdd(ssq + row, sq); }
            }
    }
};
struct EpiProj {
    static constexpr bool PERM = true, AFTER_DRAIN = false;
    bf16_t* O; const float* ropec; const float* ropes; float c2; const float* ss; const float* bias;
    __device__ __forceinline__ void operator()(const f32x4 (&acc)[2][2][4][2], const Unit& u, int wr, int wc, int fr, int fq) const {
        const int row0 = u.pm * BM + wr * 64 + fr;
        f32x4 bia[2][2];
        { const float* bp = bias + (size_t)(u.pm >> 4) * 3584 + u.pn * BM + wc * 32 + 8 * fq;
          bia[0][0] = *(const f32x4*)bp; bia[0][1] = *(const f32x4*)(bp + 4); bia[1][0] = *(const f32x4*)(bp + HALF); bia[1][1] = *(const f32x4*)(bp + HALF + 4); }
        if (u.pn < 4) {
            const float sc = (u.pn >= 2) ? 0.125f : 1.0f;
            const int i0 = 8 * fq, colb = u.pn * BM + wc * 64 + i0;
#pragma unroll
            for (int ai = 0; ai < 2; ++ai)
#pragma unroll
                for (int m = 0; m < 4; ++m) {
                    const int row = row0 + ai * HALF + m * 16, pos = row & 4095;
                    const f32x4 c0 = *(const f32x4*)(ropec + pos * 32 + i0), c1 = *(const f32x4*)(ropec + pos * 32 + i0 + 4);
                    const f32x4 s0 = *(const f32x4*)(ropes + pos * 32 + i0), s1 = *(const f32x4*)(ropes + pos * 32 + i0 + 4);
                    const float ri = __builtin_amdgcn_rsqf(ss[row] * (1.0f / 1024.0f) + 1e-6f);
                    const f32x4 xa = acc[ai][0][m][0] * ri + bia[0][0], xb = acc[ai][0][m][1] * ri + bia[0][1], ya = acc[ai][1][m][0] * ri + bia[1][0], yb = acc[ai][1][m][1] * ri + bia[1][1];
                    const f32x4 o1a = (xa * c0 - ya * s0) * sc, o1b = (xb * c1 - yb * s1) * sc, o2a = (xa * s0 + ya * c0) * sc, o2b = (xb * s1 + yb * c1) * sc;
                    bf16_t* rowp = O + (size_t)row * 3584 + colb;
                    u32x4 w; w.x = cvt_pk_bf16(o1a[0], o1a[1]); w.y = cvt_pk_bf16(o1a[2], o1a[3]); w.z = cvt_pk_bf16(o1b[0], o1b[1]); w.w = cvt_pk_bf16(o1b[2], o1b[3]);
                    *(u32x4*)rowp = w;
                    w.x = cvt_pk_bf16(o2a[0], o2a[1]); w.y = cvt_pk_bf16(o2a[2], o2a[3]); w.z = cvt_pk_bf16(o2b[0], o2b[1]); w.w = cvt_pk_bf16(o2b[2], o2b[3]);
                    *(u32x4*)(rowp + 32) = w;
                }
        } else {
            const int kind = (u.pn == 6 || u.pn == 7) ? 1 : ((u.pn == 8 || u.pn == 9) ? 2 : 0);
            const int col0 = u.pn * BM + wc * 32 + 8 * fq;
#pragma unroll
            for (int ai = 0; ai < 2; ++ai)
#pragma unroll
                for (int m = 0; m < 4; ++m) {
                    bf16_t* rowp = O + (size_t)(row0 + ai * HALF + m * 16) * 3584 + col0;
                    const float ri = __builtin_amdgcn_rsqf(ss[row0 + ai * HALF + m * 16] * (1.0f / 1024.0f) + 1e-6f);
#pragma unroll
                    for (int bj = 0; bj < 2; ++bj) {
                        f32x4 v0 = acc[ai][bj][m][0] * ri + bia[bj][0], v1 = acc[ai][bj][m][1] * ri + bia[bj][1];
                        if (kind == 1) {
#pragma unroll
                            for (int e = 0; e < 4; ++e) { v0[e] = fast_silu(v0[e]); v1[e] = fast_silu(v1[e]); }
                        } else if (kind == 2) { v0 = v0 * c2; v1 = v1 * c2; }
                        u32x4 w; w.x = cvt_pk_bf16(v0[0], v0[1]); w.y = cvt_pk_bf16(v0[2], v0[3]); w.z = cvt_pk_bf16(v1[0], v1[1]); w.w = cvt_pk_bf16(v1[2], v1[3]);
                        *(u32x4*)(rowp + bj * HALF) = w;
                    }
                }
        }
    }
};

template <class Epi, class Sched, bool ALIGN_EPI = false, bool SP2 = false>
__device__ __forceinline__ void gemm_phase(PG8_LAS unsigned char* lds, const Gemm g, const Sched& S, const Epi& E) {
    int tid_l = threadIdx.x; asm volatile("" : "+v"(tid_l));
    const int tid = tid_l, wid = __builtin_amdgcn_readfirstlane(tid >> 6), lane = tid & 63, wr = wid >> 2, wc = wid & 3, fr = lane & 15, fq = lane >> 4;
    const int K = g.K, nt = K / BK;
    unsigned voffA[2], voffB[2];
#pragma unroll
    for (int i = 0; i < 2; ++i) { int R, C; stage_rc(tid * 16 + i * 8192, R, C); const int Rb = Epi::PERM ? ((R & ~31) + perm32(R & 31)) : R;
        voffA[i] = (unsigned)(R * K + C) * 2u; voffB[i] = (unsigned)(Rb * K + C) * 2u; }
    const size_t kstep = (size_t)(BK * 2);
    const size_t hstep = (size_t)HALF * K * 2;
    const size_t tstep = 2 * hstep;
    const unsigned ldsw = (unsigned)wid * 1024u;
    const int aoff = lds_byte(wr * 64 + fr, fq * 8), boff = lds_byte(wc * 32 + fr, fq * 8);
#define PG8_SA(b, h) (((b) * 2 + (h)) * HTB)
#define PG8_SB(b, h) ((4 + (b) * 2 + (h)) * HTB)
#define PG8_STAGE(bufoff, gbase, voff) do { _Pragma("unroll") for (int _i = 0; _i < 2; ++_i) \
        __builtin_amdgcn_global_load_lds((const unsigned*)((const char*)(gbase) + (voff)[_i]), (PG8_LAS unsigned*)(lds + (bufoff) + ldsw + _i * 8192), 16, 0, 0); } while (0)
#define PG8_LDA(dst, b, h) do { _Pragma("unroll") for (int m = 0; m < 4; ++m) _Pragma("unroll") for (int k = 0; k < 2; ++k) dst[m][k] = *(const PG8_LAS bf16x8*)(lds + PG8_SA(b, h) + aoff + m * 2048 + k * 1024); } while (0)
#define PG8_LDB(dst, b, h) do { _Pragma("unroll") for (int n = 0; n < 2; ++n) _Pragma("unroll") for (int k = 0; k < 2; ++k) dst[n][k] = *(const PG8_LAS bf16x8*)(lds + PG8_SB(b, h) + boff + n * 2048 + k * 1024); } while (0)
#define PG8_MMA(ai, bj, At, Bt) do { __builtin_amdgcn_s_setprio(1); _Pragma("unroll") for (int m = 0; m < 4; ++m) _Pragma("unroll") for (int n = 0; n < 2; ++n) _Pragma("unroll") for (int k = 0; k < 2; ++k) \
        acc[ai][bj][m][n] = __builtin_amdgcn_mfma_f32_16x16x32_bf16(Bt[n][k], At[m][k], acc[ai][bj][m][n], 0, 0, 0); __builtin_amdgcn_s_setprio(0); } while (0)
#define PG8_WAIT_V(n) asm volatile("s_waitcnt vmcnt(" #n ")" ::: "memory")
#define PG8_WAIT_L(n) asm volatile("s_waitcnt lgkmcnt(" #n ")" ::: "memory")
#define PG8_BAR __builtin_amdgcn_s_barrier()
#define PG8_SCHED __builtin_amdgcn_sched_barrier(0)
    Unit cur, nxt; int ui = 0;
    if (!S.next(0, cur)) return;
    f32x4 acc[2][2][4][2];
#pragma unroll
    for (int a = 0; a < 2; ++a)
#pragma unroll
        for (int b = 0; b < 2; ++b)
#pragma unroll
            for (int m = 0; m < 4; ++m)
#pragma unroll
                for (int n = 0; n < 2; ++n) acc[a][b][m][n] = (f32x4){0.f, 0.f, 0.f, 0.f};
    bf16x8 At[4][2], B0[2][2], B1[2][2];
    const char* cA = (const char*)g.A + (size_t)cur.pm * tstep; const char* cB = (const char*)g.Bt + (size_t)cur.pn * tstep;
    S.a_ready(cur);
    if constexpr (SP2) {
        PG8_STAGE(PG8_SB(0, 0), cB, voffB); PG8_STAGE(PG8_SB(0, 1), cB + hstep, voffB); PG8_STAGE(PG8_SA(0, 0), cA, voffA); PG8_STAGE(PG8_SA(0, 1), cA + hstep, voffA);
        if (wr == 1) PG8_BAR;
        PG8_WAIT_V(2); PG8_BAR;
        PG8_STAGE(PG8_SB(1, 0), cB + kstep, voffB); PG8_STAGE(PG8_SA(1, 0), cA + kstep, voffA); PG8_STAGE(PG8_SB(1, 1), cB + hstep + kstep, voffB);
        PG8_WAIT_V(6); PG8_BAR;
    } else {
        PG8_STAGE(PG8_SB(0, 0), cB, voffB); PG8_STAGE(PG8_SA(0, 0), cA, voffA); PG8_STAGE(PG8_SB(0, 1), cB + hstep, voffB); PG8_STAGE(PG8_SA(0, 1), cA + hstep, voffA);
        if (wr == 1) PG8_BAR;
        PG8_WAIT_V(4); PG8_BAR;
        PG8_STAGE(PG8_SB(1, 0), cB + kstep, voffB); PG8_STAGE(PG8_SA(1, 0), cA + kstep, voffA); PG8_STAGE(PG8_SB(1, 1), cB + hstep + kstep, voffB);
        PG8_WAIT_V(6); PG8_BAR;
    }
    for (;;) {
        const bool has_next = S.next(ui + 1, nxt);
        const char* nA = has_next ? (const char*)g.A + (size_t)nxt.pm * tstep : cA; const char* nB = has_next ? (const char*)g.Bt + (size_t)nxt.pn * tstep : cB;
        for (int t = 0; t < nt; t += 2) {
            const bool last = (t == nt - 2);
            const char* a1 = cA + (size_t)(t + 1) * kstep;
            const char* a2 = last ? nA : cA + (size_t)(t + 2) * kstep; const char* b2 = last ? nB : cB + (size_t)(t + 2) * kstep;
            const char* a3 = a2 + kstep; const char* b3 = b2 + kstep;
            if (last && has_next) S.a_ready(nxt);
            if constexpr (SP2) {
            PG8_LDB(B0, 0, 0); PG8_LDB(B1, 0, 1); PG8_SCHED; PG8_LDA(At, 0, 0); PG8_STAGE(PG8_SA(1, 1), a1 + hstep, voffA);
            PG8_WAIT_V(8); PG8_WAIT_L(0); PG8_BAR; PG8_MMA(0, 0, At, B0); PG8_MMA(0, 1, At, B1); PG8_BAR; PG8_SCHED;
            PG8_LDA(At, 0, 1); PG8_STAGE(PG8_SB(0, 0), b2, voffB); PG8_STAGE(PG8_SB(0, 1), b2 + hstep, voffB); PG8_STAGE(PG8_SA(0, 0), a2, voffA);
            PG8_WAIT_V(8); PG8_WAIT_L(0); PG8_BAR; PG8_MMA(1, 0, At, B0); PG8_MMA(1, 1, At, B1); PG8_BAR; PG8_SCHED;
            PG8_LDB(B0, 1, 0); PG8_LDB(B1, 1, 1); PG8_SCHED; PG8_LDA(At, 1, 0); PG8_STAGE(PG8_SA(0, 1), a2 + hstep, voffA);
            PG8_WAIT_V(8); PG8_WAIT_L(0); PG8_BAR; PG8_MMA(0, 0, At, B0); PG8_MMA(0, 1, At, B1); PG8_BAR; PG8_SCHED;
            PG8_LDA(At, 1, 1); PG8_STAGE(PG8_SB(1, 0), b3, voffB); PG8_STAGE(PG8_SB(1, 1), b3 + hstep, voffB); PG8_STAGE(PG8_SA(1, 0), a3, voffA);
            PG8_WAIT_V(8); PG8_WAIT_L(0); PG8_BAR; PG8_MMA(1, 0, At, B0); PG8_MMA(1, 1, At, B1); PG8_BAR; PG8_SCHED;
            } else {
            PG8_LDB(B0, 0, 0); PG8_SCHED; PG8_LDA(At, 0, 0); PG8_STAGE(PG8_SA(1, 1), a1 + hstep, voffA);
            PG8_WAIT_L(8); PG8_BAR; PG8_WAIT_L(0); PG8_MMA(0, 0, At, B0); PG8_BAR; PG8_SCHED;
            PG8_LDB(B1, 0, 1); PG8_STAGE(PG8_SB(0, 0), b2, voffB);
            PG8_BAR; PG8_WAIT_L(0); PG8_MMA(0, 1, At, B1); PG8_BAR;
            PG8_LDA(At, 0, 1); PG8_STAGE(PG8_SA(0, 0), a2, voffA);
            PG8_BAR; PG8_WAIT_L(0); PG8_MMA(1, 0, At, B0); PG8_BAR; PG8_SCHED;
            PG8_STAGE(PG8_SB(0, 1), b2 + hstep, voffB);
            PG8_WAIT_V(6); PG8_BAR; PG8_MMA(1, 1, At, B1); PG8_BAR;
            PG8_LDB(B0, 1, 0); PG8_SCHED; PG8_LDA(At, 1, 0); PG8_STAGE(PG8_SA(0, 1), a2 + hstep, voffA);
            PG8_WAIT_L(8); PG8_BAR; PG8_WAIT_L(0); PG8_MMA(0, 0, At, B0); PG8_BAR; PG8_SCHED;
            PG8_LDB(B1, 1, 1); PG8_STAGE(PG8_SB(1, 0), b3, voffB);
            PG8_BAR; PG8_WAIT_L(0); PG8_MMA(0, 1, At, B1); PG8_BAR;
            PG8_LDA(At, 1, 1); PG8_STAGE(PG8_SA(1, 0), a3, voffA);
            PG8_BAR; PG8_WAIT_L(0); PG8_MMA(1, 0, At, B0); PG8_BAR; PG8_SCHED;
            PG8_STAGE(PG8_SB(1, 1), b3 + hstep, voffB);
            PG8_WAIT_V(6); PG8_BAR; PG8_MMA(1, 1, At, B1); PG8_BAR;
            }
        }
        if constexpr (ALIGN_EPI) { if (wr == 0) PG8_BAR; }
        if constexpr (!Epi::AFTER_DRAIN) { E(acc, cur, wr, wc, fr, fq); S.done(cur); }
        if (!has_next) break;
#pragma unroll
        for (int a = 0; a < 2; ++a)
#pragma unroll
            for (int b = 0; b < 2; ++b)
#pragma unroll
                for (int m = 0; m < 4; ++m)
#pragma unroll
                    for (int n = 0; n < 2; ++n) acc[a][b][m][n] = (f32x4){0.f, 0.f, 0.f, 0.f};
        cur = nxt; cA = nA; cB = nB; ++ui;
        if constexpr (ALIGN_EPI) { if (wr == 1) PG8_BAR; }
    }
    PG8_WAIT_V(0);
    if constexpr (!ALIGN_EPI) { if (wr == 0) PG8_BAR; }
    PG8_BAR;
    if constexpr (Epi::AFTER_DRAIN) { E.fused(acc, cur, wr, wc, fr, fq, lds, wid, lane); S.done(cur); }
#undef PG8_SA
#undef PG8_SB
#undef PG8_STAGE
#undef PG8_LDA
#undef PG8_LDB
#undef PG8_MMA
#undef PG8_WAIT_V
#undef PG8_WAIT_L
#undef PG8_BAR
#undef PG8_SCHED
}
}
#include <hip/hip_bf16.h>
#include <cmath>
namespace attn_body {
using bf16=__hip_bfloat16;
using bf16x8=__attribute__((ext_vector_type(8)))short;
using s16x4=__attribute__((ext_vector_type(4)))short;
using f32x16=__attribute__((ext_vector_type(16)))float;
using u32x4=__attribute__((ext_vector_type(4)))unsigned;
constexpr int SEQ=4096,D=64,PQ=3584,PO=1024;
constexpr int NW=8,QBLK=32,QB=QBLK*NW,KVBLK=64,NQB=SEQ/QB;
constexpr int ATTN_UNIT_ROWS=QB;
__device__ __forceinline__ int crow(int r,int hi){return (r&3)+8*(r>>2)+4*hi;}
#define SBAR() __builtin_amdgcn_sched_barrier(0)
typedef __attribute__((address_space(3))) const float* lds_cfptr;
__device__ __forceinline__ void cmask(f32x16&p0,f32x16&p1,int jb,int qrel,int hi,lds_cfptr rt){
  const float NEG=-INFINITY; const int base=qrel-64*jb-4*hi;
  lds_cfptr a=rt+(383-base);
  #pragma unroll
  for(int g=0;g<4;++g){
    #pragma unroll
    for(int rr=0;rr<4;++rr){const int r=4*g+rr,o=(r&3)+8*(r>>2);
      const float d0=a[o],d1=a[o+32];
      p0[r]=(base-o<0)?NEG:p0[r]+d0; p1[r]=(base-o-32<0)?NEG:p1[r]+d1;}
    __builtin_amdgcn_sched_barrier(0);
  }
}

constexpr int NSLOT=3, SLOTB=8192;
constexpr int LDS_K=0, LDS_V=NSLOT*SLOTB, LDS_WS=2*NSLOT*SLOTB, LDS_OST=LDS_WS+NW*64*4, LDS_TAB=LDS_OST+NW*4096, LDS_BYTES=LDS_TAB+2560;
constexpr float C2=0.125f*1.4426950408889634f;
__device__ __forceinline__ void glds16(const void*gsrc,unsigned lds_dst){unsigned keep;
  asm volatile("s_mov_b32 %0, m0\n\ts_mov_b32 m0, %2\n\ts_nop 0\n\tglobal_load_lds_dwordx4 %1, off\n\ts_mov_b32 m0, %0":"=&s"(keep):"v"(gsrc),"s"(lds_dst):"memory");}
__device__ __forceinline__ float max3f(float a,float b,float c){float r;asm("v_max3_f32 %0, %1, %2, %3":"=v"(r):"v"(a),"v"(b),"v"(c));return r;}
__device__ __forceinline__ float max2f(float a,float b){float r;asm("v_max_f32_e32 %0, %1, %2":"=v"(r):"v"(a),"v"(b));return r;}
__device__ __forceinline__ float fadd_s(float a,float b){float r;asm("v_add_f32_e32 %0, %1, %2":"=v"(r):"v"(a),"v"(b));return r;}
__device__ __forceinline__ float fsub_s(float a,float b){float r;asm("v_sub_f32_e32 %0, %1, %2":"=v"(r):"v"(a),"v"(b));return r;}
typedef float f32x2_t __attribute__((ext_vector_type(2))); typedef __bf16 bf16x2_t __attribute__((ext_vector_type(2)));
__device__ __forceinline__ unsigned cvtpk_s(float lo,float hi){f32x2_t v={lo,hi};bf16x2_t b=__builtin_convertvector(v,bf16x2_t);return __builtin_bit_cast(unsigned,b);}
#define WAIT_BAR(N) asm volatile("s_waitcnt vmcnt(" #N ") lgkmcnt(0)\n\ts_barrier":::"memory")

__device__ __forceinline__ void qkt(f32x16&p0,f32x16&p1,const char*Kslot,const bf16x8*qr,const f32x16&negm,int r32,int hi){
  const char*kb=Kslot+hi*1024+r32*16;
  #pragma unroll
  for(int d0=0;d0<4;++d0){
    const bf16x8 b0=*reinterpret_cast<const bf16x8*>(kb+d0*2048);
    const bf16x8 b1=*reinterpret_cast<const bf16x8*>(kb+d0*2048+512);
    if(d0==0){p0=__builtin_amdgcn_mfma_f32_32x32x16_bf16(b0,qr[0],negm,0,0,0);p1=__builtin_amdgcn_mfma_f32_32x32x16_bf16(b1,qr[0],negm,0,0,0);}
    else{p0=__builtin_amdgcn_mfma_f32_32x32x16_bf16(b0,qr[d0],p0,0,0,0);p1=__builtin_amdgcn_mfma_f32_32x32x16_bf16(b1,qr[d0],p1,0,0,0);}}
}
typedef __attribute__((address_space(3))) const char* lds_cptr;
typedef short v4i16_t __attribute__((ext_vector_type(4)));
__device__ __forceinline__ void kload8(bf16x8*kf,lds_cptr kp){
  kf[0]=*(const __attribute__((address_space(3))) bf16x8*)(kp);      kf[1]=*(const __attribute__((address_space(3))) bf16x8*)(kp+512);
  kf[2]=*(const __attribute__((address_space(3))) bf16x8*)(kp+2048); kf[3]=*(const __attribute__((address_space(3))) bf16x8*)(kp+2560);
  kf[4]=*(const __attribute__((address_space(3))) bf16x8*)(kp+4096); kf[5]=*(const __attribute__((address_space(3))) bf16x8*)(kp+4608);
  kf[6]=*(const __attribute__((address_space(3))) bf16x8*)(kp+6144); kf[7]=*(const __attribute__((address_space(3))) bf16x8*)(kp+6656);
}
__device__ __forceinline__ void kload2(bf16x8*kf,lds_cptr kp,int j){ kf[2*j]=*(const __attribute__((address_space(3))) bf16x8*)(kp+j*2048); kf[2*j+1]=*(const __attribute__((address_space(3))) bf16x8*)(kp+j*2048+512); }
__device__ __forceinline__ s16x4 vtr(lds_cptr p){ return __builtin_bit_cast(s16x4,__builtin_amdgcn_ds_read_tr16_b64_v4i16((__attribute__((address_space(3))) v4i16_t*)p)); }
__device__ __forceinline__ float rowmax(const f32x16&p0,const f32x16&p1){
  float a=max3f(p0[0],p0[1],p1[0]),b=max3f(p0[2],p0[3],p1[1]);a=max3f(a,p1[2],p1[3]);
  #pragma unroll
  for(int r=4;r<16;r+=4){a=max3f(a,p0[r],p0[r+1]);b=max3f(b,p0[r+2],p0[r+3]);a=max3f(a,p1[r],p1[r+1]);b=max3f(b,p1[r+2],p1[r+3]);}
  const float m=max2f(a,b);
  auto rr=__builtin_amdgcn_permlane32_swap(__float_as_uint(m),__float_as_uint(m),false,false);
  return max2f(__uint_as_float(rr[0]),__uint_as_float(rr[1]));
}
__device__ __forceinline__ void pv(f32x16*o,int vb,bf16x8 pa0,bf16x8 pa1,bf16x8 pa2,bf16x8 pa3){
  #pragma unroll
  for(int d0=0;d0<2;++d0){s16x4 lo[4],hi[4];
    #pragma unroll
    for(int ks=0;ks<4;++ks){
      asm volatile("ds_read_b64_tr_b16 %0,%1 offset:%c2":"=&v"(lo[ks]):"v"(vb),"i"(d0*4096+ks*1024):"memory");
      asm volatile("ds_read_b64_tr_b16 %0,%1 offset:%c2":"=&v"(hi[ks]):"v"(vb),"i"(d0*4096+ks*1024+512):"memory");}
    asm volatile("s_waitcnt lgkmcnt(0)":::"memory");SBAR();
    #define PK(k) (bf16x8){lo[k][0],lo[k][1],lo[k][2],lo[k][3],hi[k][0],hi[k][1],hi[k][2],hi[k][3]}
    o[d0]=__builtin_amdgcn_mfma_f32_32x32x16_bf16(pa0,PK(0),o[d0],0,0,0);
    o[d0]=__builtin_amdgcn_mfma_f32_32x32x16_bf16(pa1,PK(1),o[d0],0,0,0);
    o[d0]=__builtin_amdgcn_mfma_f32_32x32x16_bf16(pa2,PK(2),o[d0],0,0,0);
    o[d0]=__builtin_amdgcn_mfma_f32_32x32x16_bf16(pa3,PK(3),o[d0],0,0,0);
    #undef PK
  }
}

#ifndef ATTN_STORE16
#define ATTN_STORE16(p,v) (*(u32x4*)(p)=(v))
#endif
template<int THRL> __device__ __forceinline__ void attn_unit(int qb,const bf16*Qb,const bf16*__restrict__ Kh,const bf16*__restrict__ Vh,bf16*Ob,const float*tabg,float cfar,char*shm){
  int tid_l=threadIdx.x; asm volatile("":"+v"(tid_l));
  const int tid=tid_l,lane=tid&63,r32=lane&31,hi=lane>>5; const int wid=__builtin_amdgcn_readfirstlane(tid>>6);
  const int q0=qb*QB;
  const bf16*Qw=Qb+(long)(q0+wid*QBLK)*PQ;
  const unsigned lds0=(unsigned)(uintptr_t)shm;
  float*wsf=(float*)(shm+LDS_WS)+wid*64;
  const bf16*ksrc=Kh+(long)lane*PQ+wid*8;
  const bf16*vsrc=Vh+(long)(16*(wid&3)+(lane>>2))*PQ+(wid>>2)*32+(lane&3)*8;
  const unsigned kdst=lds0+LDS_K+wid*1024, vdst=lds0+LDS_V+wid*1024;
  #define DMA_K(t,slot) glds16(ksrc+(long)(t)*KVBLK*PQ,(unsigned)__builtin_amdgcn_readfirstlane(kdst+(slot)))
  #define DMA_V(t,slot) glds16(vsrc+(long)(t)*KVBLK*PQ,(unsigned)__builtin_amdgcn_readfirstlane(vdst+(slot)))
  const int vb0=(int)(lds0+LDS_V)+((lane>>4)&1)*32+(lane&3)*8+(4*hi+((lane&15)>>2))*64;
  const char*Kbase=shm+LDS_K; bf16x8 kf[8];
  const lds_cptr shm3=(lds_cptr)shm; const lds_cptr kp0=shm3+LDS_K+hi*1024+r32*16; const lds_cptr vp0=shm3+LDS_V+((lane>>4)&1)*32+(lane&3)*8+(4*hi+((lane&15)>>2))*64;
  const int NT=(q0+QB)/KVBLK;
  const lds_cfptr tab=(lds_cfptr)((lds_cptr)shm+LDS_TAB);
  for(int j=tid;j<640;j+=512){const int n=383-j; ((__attribute__((address_space(3))) float*)((__attribute__((address_space(3))) char*)shm+LDS_TAB))[j]=(n>=0&&n<113)?tabg[n]:0.f;}
  DMA_K(0,0);DMA_V(0,0);DMA_K(1,SLOTB);
  bf16x8 qr[4];
  #pragma unroll
  for(int d0=0;d0<4;++d0)qr[d0]=*reinterpret_cast<const bf16x8*>(&Qw[(long)r32*PQ+d0*16+hi*8]);
  float mhat=0.f,l_reg=0.f;f32x16 o[2];o[0]=f32x16{};o[1]=f32x16{};f32x16 negm;
  #pragma unroll
  for(int r=0;r<16;++r)negm[r]=cfar;
  asm volatile("":"+v"(negm));
  const int qrel=wid*QBLK+r32;
  #define CMASK(P0,P1,t) do{int jb_=(t)-(NT-4); if(jb_>=-2)cmask(P0,P1,jb_,qrel,hi,tab);}while(0)
  bool resc=false;
  #define START(P0,P1) do{ const float rm=rowmax(P0,P1); resc=false; \
    { const float dl=rm; mhat=fadd_s(mhat,dl); \
      _Pragma("unroll") for(int r=0;r<16;++r){P0[r]=fsub_s(P0[r],dl);P1[r]=fsub_s(P1[r],dl);} \
      _Pragma("unroll") for(int r=0;r<16;++r)negm[r]=cfar-mhat; asm volatile("":"+v"(negm)); } \
    _Pragma("unroll") for(int r=0;r<16;++r)P0[r]=__builtin_amdgcn_exp2f(P0[r]); }while(0)
  #define RESC() do{ if(resc){ asm volatile("s_waitcnt lgkmcnt(0)":::"memory"); \
      _Pragma("unroll") for(int d_=0;d_<2;++d_) _Pragma("unroll") for(int r=0;r<16;++r)o[d_][r]*=wsf[crow(r,hi)]; } }while(0)
  f32x16 pA0,pA1,pB0,pB1;
  int sl_prev=0,sl_cur=0,sl_next=SLOTB;
  #define ROT() do{sl_prev=sl_cur;sl_cur=sl_next;sl_next=(sl_next==(NSLOT-1)*SLOTB)?0:sl_next+SLOTB;}while(0)
  DMA_K(2,2*SLOTB);
  WAIT_BAR(3);
  qkt(pA0,pA1,Kbase,qr,negm,r32,hi);asm volatile("s_nop 15\n\ts_nop 7":"+v"(pA0),"+v"(pA1));CMASK(pA0,pA1,0);
  START(pA0,pA1);
  _Pragma("unroll") for(int r=0;r<16;++r)pA1[r]=__builtin_amdgcn_exp2f(pA1[r]);
  WAIT_BAR(0);
  DMA_K(3,0);DMA_V(1,SLOTB);
  ROT();
  kload8(kf,kp0+sl_cur);
  WAIT_BAR(2);
  s16x4 vlo[8],vhi[8]; u32x4 pw0,pw1,pw2,pw3;
  #define PKW(P,B) cvtpk_s(P[B],P[B+1])
  #define PAF(k) __builtin_bit_cast(bf16x8,pw##k)
  #define VFR(i) (bf16x8){vlo[i][0],vlo[i][1],vlo[i][2],vlo[i][3],vhi[i][0],vhi[i][1],vhi[i][2],vhi[i][3]}
  #define PIN(x) asm volatile("":"+v"(x))
  #define MX3(a,b,c) __builtin_fmaxf(__builtin_fmaxf((a),(b)),(c))
  #define GAPA(MF,A0,A1,A2,A3,W0,W1,PW) do{ MF; sacc+=A0; sacc+=A1; sacc+=A2; sacc+=A3; PIN(sacc); W0; W1; PIN(PW); SBAR(); }while(0)
  #define EX(v) __builtin_amdgcn_exp2f(v)
  #define GAPB(MF,X,B) do{ MF; X[B]=EX(X[B]); X[B+1]=EX(X[B+1]); X[B+2]=EX(X[B+2]); X[B+3]=EX(X[B+3]); PIN(X); SBAR(); }while(0)
  #define VRD(i) do{ vlo[i]=vtr(vp_+(((i)>>2)*4096+((i)&3)*1024)); vhi[i]=vtr(vp_+(((i)>>2)*4096+((i)&3)*1024+512)); }while(0)
  #define KRD(G,j) do{ if(G){ kload2(kf,kp0+sl_next,j); SBAR(); } }while(0)
  #define STEP(C0,C1,P0,P1,t,GK,GV,GL) do{ SBAR(); \
    const lds_cptr vp_=vp0+sl_prev; \
    VRD(0); SBAR(); float sacc=(P0[0]+P0[1]); \
    GAPA(C0=__builtin_amdgcn_mfma_f32_32x32x16_bf16(kf[0],qr[0],negm,0,0,0), P0[2],P0[3],P0[4],P0[5],     pw0[0]=PKW(P0,0), pw0[1]=PKW(P0,2), pw0); \
    VRD(4); SBAR(); GAPA(C1=__builtin_amdgcn_mfma_f32_32x32x16_bf16(kf[1],qr[0],negm,0,0,0), P0[6],P0[7],P0[8],P0[9],     pw0[2]=PKW(P0,4), pw0[3]=PKW(P0,6), pw0); \
    VRD(1); SBAR(); GAPA(C0=__builtin_amdgcn_mfma_f32_32x32x16_bf16(kf[2],qr[1],C0,0,0,0),   P0[10],P0[11],P0[12],P0[13], pw1[0]=PKW(P0,8), pw1[1]=PKW(P0,10), pw1); \
    VRD(5); SBAR(); GAPA(C1=__builtin_amdgcn_mfma_f32_32x32x16_bf16(kf[3],qr[1],C1,0,0,0),   P0[14],P0[15],P1[0],P1[1],   pw1[2]=PKW(P0,12),pw1[3]=PKW(P0,14), pw1); \
    VRD(2); SBAR(); GAPA(C0=__builtin_amdgcn_mfma_f32_32x32x16_bf16(kf[4],qr[2],C0,0,0,0),   P1[2],P1[3],P1[4],P1[5],     pw2[0]=PKW(P1,0), pw2[1]=PKW(P1,2), pw2); \
    VRD(6); SBAR(); GAPA(C1=__builtin_amdgcn_mfma_f32_32x32x16_bf16(kf[5],qr[2],C1,0,0,0),   P1[6],P1[7],P1[8],P1[9],     pw2[2]=PKW(P1,4), pw2[3]=PKW(P1,6), pw2); \
    VRD(3); SBAR(); GAPA(C0=__builtin_amdgcn_mfma_f32_32x32x16_bf16(kf[6],qr[3],C0,0,0,0),   P1[10],P1[11],P1[12],P1[13], pw3[0]=PKW(P1,8), pw3[1]=PKW(P1,10), pw3); \
    VRD(7); SBAR(); GAPA(C1=__builtin_amdgcn_mfma_f32_32x32x16_bf16(kf[7],qr[3],C1,0,0,0),   P1[14],P1[15],0.f,0.f,       pw3[2]=PKW(P1,12),pw3[3]=PKW(P1,14), pw3); \
    l_reg+=sacc; \
    if(GK){DMA_K((t)+3,sl_cur);} if(GV){DMA_V((t)+1,sl_next);} \
    CMASK(C0,C1,t); \
    { float a=MX3(C0[0],C0[1],C1[0]),b=MX3(C0[2],C0[3],C1[1]); a=MX3(a,C1[2],C1[3]); \
      _Pragma("unroll") for(int r=4;r<16;r+=4){a=MX3(a,C0[r],C0[r+1]);b=MX3(b,C0[r+2],C0[r+3]);a=MX3(a,C1[r],C1[r+1]);b=MX3(b,C1[r+2],C1[r+3]);} \
      float rm=__builtin_fmaxf(a,b); { auto rr=__builtin_amdgcn_permlane32_swap(__float_as_uint(rm),__float_as_uint(rm),false,false); rm=__builtin_fmaxf(__uint_as_float(rr[0]),__uint_as_float(rr[1])); } \
      resc=false; \
      if(__builtin_expect(__any(rm>(float)THRL),0)){ const float dl=__builtin_fmaxf(rm,0.f); mhat+=dl; \
        _Pragma("unroll") for(int r=0;r<16;++r){C0[r]-=dl;C1[r]-=dl;} \
        _Pragma("unroll") for(int r=0;r<16;++r)negm[r]=cfar-mhat; asm volatile("":"+v"(negm)); \
        const float f=__builtin_amdgcn_exp2f(-dl); l_reg*=f; if(hi==0)wsf[r32]=f; resc=true; } } \
    SBAR(); \
    GAPB(o[0]=__builtin_amdgcn_mfma_f32_32x32x16_bf16(PAF(0),VFR(0),o[0],0,0,0), C0,0); \
    GAPB(o[1]=__builtin_amdgcn_mfma_f32_32x32x16_bf16(PAF(0),VFR(4),o[1],0,0,0), C0,4); \
    KRD(GL,0); GAPB(o[0]=__builtin_amdgcn_mfma_f32_32x32x16_bf16(PAF(1),VFR(1),o[0],0,0,0), C0,8); \
    KRD(GL,1); GAPB(o[1]=__builtin_amdgcn_mfma_f32_32x32x16_bf16(PAF(1),VFR(5),o[1],0,0,0), C0,12); \
    KRD(GL,2); GAPB(o[0]=__builtin_amdgcn_mfma_f32_32x32x16_bf16(PAF(2),VFR(2),o[0],0,0,0), C1,0); \
    KRD(GL,3); GAPB(o[1]=__builtin_amdgcn_mfma_f32_32x32x16_bf16(PAF(2),VFR(6),o[1],0,0,0), C1,4); \
    GAPB(o[0]=__builtin_amdgcn_mfma_f32_32x32x16_bf16(PAF(3),VFR(3),o[0],0,0,0), C1,8); \
    GAPB(o[1]=__builtin_amdgcn_mfma_f32_32x32x16_bf16(PAF(3),VFR(7),o[1],0,0,0), C1,12); \
    }while(0)
  int t=1;
  #undef CMASK
  #define CMASK(P0,P1,t) do{}while(0)
  for(;t+7<NT;t+=2){
    STEP(pB0,pB1,pA0,pA1,t,true,true,true);     WAIT_BAR(2); RESC(); ROT();
    STEP(pA0,pA1,pB0,pB1,t+1,true,true,true);   WAIT_BAR(2); RESC(); ROT();
  }
  #undef CMASK
  #define CMASK(P0,P1,t) do{int jb_=(t)-(NT-4); if(jb_>=-2)cmask(P0,P1,jb_,qrel,hi,tab);}while(0)
  #define ENDW(tt) do{ if((tt)+3<NT){WAIT_BAR(2);} else if((tt)+2<NT){WAIT_BAR(1);} else {WAIT_BAR(0);} }while(0)
  for(;t+1<NT;t+=2){
    STEP(pB0,pB1,pA0,pA1,t,(t+3<NT),(t+1<NT),(t+1<NT));       ENDW(t);   RESC(); ROT();
    STEP(pA0,pA1,pB0,pB1,t+1,(t+4<NT),(t+2<NT),(t+2<NT));     ENDW(t+1); RESC(); ROT();
  }
  STEP(pB0,pB1,pA0,pA1,NT-1,false,false,false); RESC();
  { float sacc=pB0[0]+pB0[1]; _Pragma("unroll") for(int r=2;r<16;++r)sacc+=pB0[r]; _Pragma("unroll") for(int r=0;r<16;++r)sacc+=pB1[r]; l_reg+=sacc;
    pw0=(u32x4){PKW(pB0,0),PKW(pB0,2),PKW(pB0,4),PKW(pB0,6)};pw1=(u32x4){PKW(pB0,8),PKW(pB0,10),PKW(pB0,12),PKW(pB0,14)};pw2=(u32x4){PKW(pB1,0),PKW(pB1,2),PKW(pB1,4),PKW(pB1,6)};pw3=(u32x4){PKW(pB1,8),PKW(pB1,10),PKW(pB1,12),PKW(pB1,14)};
    SBAR(); pv(o,vb0+sl_cur,PAF(0),PAF(1),PAF(2),PAF(3)); }
  #undef PKW
  #undef PAF
  #undef VFR
  #undef PIN
  #undef MX3
  #undef GAPA
  #undef GAPB
  #undef EX
  #undef VRD
  #undef KRD
  #undef STEP
  #undef ENDW
  {auto rr=__builtin_amdgcn_permlane32_swap(__float_as_uint(l_reg),__float_as_uint(l_reg),false,false);l_reg=__uint_as_float(rr[0])+__uint_as_float(rr[1]);}
  if(hi==0)wsf[32+r32]=l_reg;asm volatile("s_waitcnt lgkmcnt(0)":::"memory");
  float rli[16];
  #pragma unroll
  for(int r=0;r<16;++r)rli[r]=__builtin_amdgcn_rcpf(wsf[32+crow(r,hi)]);
  bf16*Ow=Ob+(long)(q0+wid*QBLK)*PO;
  { bf16*stg=(bf16*)(shm+LDS_OST)+wid*2048;
    #pragma unroll
    for(int r=0;r<16;++r){const int orow=crow(r,hi);
      #pragma unroll
      for(int d0=0;d0<2;++d0)stg[orow*64+d0*32+r32]=__float2bfloat16(o[d0][r]*rli[r]);}
    asm volatile("s_waitcnt lgkmcnt(0)":::"memory");
    #pragma unroll
    for(int i=0;i<4;++i){const int row=i*8+(lane>>3),ch=lane&7; const u32x4 v=*(const u32x4*)(stg+row*64+ch*8); ATTN_STORE16(Ow+(long)row*PO+ch*8,v);} }
  asm volatile("s_waitcnt lgkmcnt(0)\n\ts_barrier":::"memory");
  #undef DMA_K
  #undef DMA_V
  #undef CMASK
  #undef START
  #undef RESC
  #undef ROT
}
constexpr int ATTN_LDS_BYTES=LDS_BYTES;
template<int THRL=8> __device__ __forceinline__ void attn_phase(char*lds,const bf16*P,bf16*O,const float*TAB,const float*CFAR,int grid,int block){
  const int vcu=(grid%8==0)?(block%8)*(grid/8)+block/8:block;
  for(int vh=vcu>>1;vh<128;vh+=(grid>>1)){
    const int half=vh&1,m=(vh>>1)&1,h=(vh>>2)&3,b=vh>>4;
    const bf16*Pb=P+(long)b*SEQ*PQ;
    const float cf=CFAR[h];
    for(int i=0;i<8;++i){ const int s=4*(vcu&1)+(i>>1); const int qb=(i&1)?15-s:s;
      attn_unit<THRL>(qb,Pb+2048+h*128+m*64,Pb+2560+h*128+m*64,Pb+3072+h*128+half*64,O+(long)b*SEQ*PO+((h*2+m)*2+half)*64,TAB+h*128,cf,lds); }
  }
}
#undef SBAR
#undef WAIT_BAR
}
namespace ret {
typedef short bf16x8 __attribute__((ext_vector_type(8)));
typedef short s16x4 __attribute__((ext_vector_type(4)));
typedef float f32x4 __attribute__((ext_vector_type(4)));
typedef unsigned u32x4 __attribute__((ext_vector_type(4)));
typedef unsigned u32x2 __attribute__((ext_vector_type(2)));
#define RLAS __attribute__((address_space(3)))
typedef RLAS unsigned char* ldsptr;
constexpr int RS = 72, PS = 136;
constexpr int OFF_Q = 0, OFF_K = 18432, OFF_KZ = 36864, OFF_V = 55296, OFF_RT = 73728, OFF_P = 82944, RET_LDS = 117760;
constexpr int NINP = 3584, SEQL = 4096;
__device__ __forceinline__ unsigned f2bf_(float f) { unsigned u = __builtin_bit_cast(unsigned, f); return (u + 0x7fffu + ((u >> 16) & 1u)) >> 16; }
__device__ __forceinline__ unsigned pk2_(float lo, float hi) { return f2bf_(lo) | (f2bf_(hi) << 16); }
__device__ __forceinline__ float bf2f_(unsigned h) { return __builtin_bit_cast(float, h << 16); }
__device__ __forceinline__ bf16x8 ldA(ldsptr base, int row, int col, int stride) { return *(const RLAS bf16x8*)(base + (row * stride + col) * 2); }
__device__ __forceinline__ bf16x8 ldT(ldsptr base, int k0, int n0, int c, int q) {
    typedef short v4i16_t __attribute__((ext_vector_type(4)));
    ldsptr p = base + ((k0 + 8 * q + (c >> 2)) * RS + n0 + 4 * (c & 3)) * 2;
    const s16x4 lo = __builtin_bit_cast(s16x4, __builtin_amdgcn_ds_read_tr16_b64_v4i16((RLAS v4i16_t*)p));
    const s16x4 hi = __builtin_bit_cast(s16x4, __builtin_amdgcn_ds_read_tr16_b64_v4i16((RLAS v4i16_t*)(p + 4 * RS * 2)));
    return (bf16x8){lo[0], lo[1], lo[2], lo[3], hi[0], hi[1], hi[2], hi[3]};
}
#define MFMA16(a, b, c) __builtin_amdgcn_mfma_f32_16x16x32_bf16((a), (b), (c), 0, 0, 0)

__device__ __forceinline__ void state_update(ldsptr lds, f32x4 (&acc_s)[2], float gc, int w, int c, int q) {
    const int dt = w >> 1, et0 = 2 * (w & 1);
    acc_s[0] = acc_s[0] * gc; acc_s[1] = acc_s[1] * gc;
#pragma unroll
    for (int ks = 0; ks < 4; ++ks) {
        const bf16x8 a = ldT(lds + OFF_KZ, 32 * ks, 16 * dt, c, q);
#pragma unroll
        for (int t2 = 0; t2 < 2; ++t2) acc_s[t2] = MFMA16(a, ldT(lds + OFF_V, 32 * ks, 16 * (et0 + t2), c, q), acc_s[t2]);
    }
}
__device__ __forceinline__ float head_l2g(int h) { return log1pf(-exp2f(-5.0f - (float)h)) * 1.4426950408889634f; }

struct Regs3 { u32x4 q[2], k[2], v[2]; };
template <bool WITH_Q> __device__ __forceinline__ void load_regs(Regs3& R, const unsigned short* Pb, int row0, int h, int tid) {
#pragma unroll
    for (int u = 0; u < 2; ++u) {
        const int pid = tid + 512 * u, row = pid >> 3, cp = pid & 7;
        const unsigned short* src = Pb + (size_t)(row0 + row) * NINP + h * 64 + 8 * cp;
        if (WITH_Q) R.q[u] = *(const u32x4*)src;
        R.k[u] = *(const u32x4*)(src + 512); R.v[u] = *(const u32x4*)(src + 1024);
    }
}
template <bool WITH_Q> __device__ __forceinline__ void store_regs(ldsptr lds, const Regs3& R, float l2g, int tid) {
#pragma unroll
    for (int u = 0; u < 2; ++u) {
        const int pid = tid + 512 * u, row = pid >> 3, cp = pid & 7;
        const int off = (row * RS + 8 * cp) * 2;
        const u32x4 kv = R.k[u];
        if (WITH_Q) { *(RLAS u32x4*)(lds + OFF_Q + off) = R.q[u]; *(RLAS u32x4*)(lds + OFF_K + off) = kv; }
        *(RLAS u32x4*)(lds + OFF_V + off) = R.v[u];
        const float z = __builtin_amdgcn_exp2f((float)(127 - row) * l2g);
        u32x4 kz;
        kz.x = pk2_(bf2f_(kv.x & 0xffffu) * z, bf2f_(kv.x >> 16) * z); kz.y = pk2_(bf2f_(kv.y & 0xffffu) * z, bf2f_(kv.y >> 16) * z);
        kz.z = pk2_(bf2f_(kv.z & 0xffffu) * z, bf2f_(kv.z >> 16) * z); kz.w = pk2_(bf2f_(kv.w & 0xffffu) * z, bf2f_(kv.w >> 16) * z);
        *(RLAS u32x4*)(lds + OFF_KZ + off) = kz;
    }
}
__device__ __forceinline__ void phase_a(unsigned char* lds_, const unsigned short* PROJ, f32x4* GS, int grid, int block) {
    ldsptr lds = (ldsptr)lds_;
    int tid_l = threadIdx.x; asm volatile("" : "+v"(tid_l));
    const int tid = tid_l, lane = tid & 63, w = __builtin_amdgcn_readfirstlane(tid >> 6), c = lane & 15, q = lane >> 4;
    for (int uid = block; uid < 512; uid += grid) {
        const int bh = uid >> 3, g = uid & 7, b = bh >> 3, h = bh & 7;
        const float l2g = head_l2g(h), gc = exp2f(128.0f * l2g);
        const unsigned short* Pb = PROJ + (size_t)b * SEQL * NINP;
        f32x4 acc_s[2] = {(f32x4){0.f, 0.f, 0.f, 0.f}, (f32x4){0.f, 0.f, 0.f, 0.f}};
        Regs3 R; load_regs<false>(R, Pb, (4 * g) * 128, h, tid);
        for (int i = 0; i < 4; ++i) {
            store_regs<false>(lds, R, l2g, tid);
            if (i < 3) load_regs<false>(R, Pb, (4 * g + i + 1) * 128, h, tid);
            __syncthreads();
            state_update(lds, acc_s, gc, w, c, q);
            __syncthreads();
        }
        GS[((size_t)(uid * 8 + w) * 2 + 0) * 64 + lane] = acc_s[0];
        GS[((size_t)(uid * 8 + w) * 2 + 1) * 64 + lane] = acc_s[1];
    }
}
__device__ __forceinline__ void phase_b(unsigned char* lds_, const unsigned short* PROJ, const f32x4* GS, const float* gs, unsigned short* Y, int grid, int block) {
    ldsptr lds = (ldsptr)lds_;
    int tid_l = threadIdx.x; asm volatile("" : "+v"(tid_l));
    const int tid = tid_l, lane = tid & 63, w = __builtin_amdgcn_readfirstlane(tid >> 6), c = lane & 15, q = lane >> 4;
    const int rowl = lane >> 2, cq = lane & 3;
    for (int uid = block; uid < 512; uid += grid) {
        const int bh = uid >> 3, g = uid & 7, b = bh >> 3, h = bh & 7;
        const float l2g = head_l2g(h), gc = exp2f(128.0f * l2g);
        const unsigned short* Pb = PROJ + (size_t)b * SEQL * NINP;
        Regs3 R; load_regs<true>(R, Pb, (4 * g) * 128, h, tid);
        f32x4 acc_s[2] = {(f32x4){0.f, 0.f, 0.f, 0.f}, (f32x4){0.f, 0.f, 0.f, 0.f}};
        for (int gp = 0; gp < g; ++gp) {
            const float wgt = exp2f(512.0f * (float)(g - 1 - gp) * l2g);
            const size_t base = ((size_t)((bh * 8 + gp) * 8 + w) * 2) * 64 + lane;
            acc_s[0] += GS[base] * wgt; acc_s[1] += GS[base + 64] * wgt;
        }
        const int dt = w >> 1, et0 = 2 * (w & 1);
        float gr[4];
#pragma unroll
        for (int r = 0; r < 4; ++r) gr[r] = exp2f(-(float)r * l2g);
        f32x4 gsv[4];
#pragma unroll
        for (int j = 0; j < 4; ++j) gsv[j] = *(const f32x4*)(gs + h * 64 + 16 * cq + 4 * j);
        for (int i = 0; i < 4; ++i) {
            const int row0 = (4 * g + i) * 128;
#pragma unroll
            for (int t2 = 0; t2 < 2; ++t2) { u32x2 v; v.x = pk2_(acc_s[t2][0], acc_s[t2][1]); v.y = pk2_(acc_s[t2][2], acc_s[t2][3]);
                *(RLAS u32x2*)(lds + OFF_RT + ((16 * (et0 + t2) + c) * RS + 16 * dt + 4 * q) * 2) = v; }
            store_regs<true>(lds, R, l2g, tid);
            if (i < 3) load_regs<true>(R, Pb, row0 + 128, h, tid);
            const unsigned short* gsrc = Pb + (size_t)(row0 + 16 * w + rowl) * NINP + 1536 + h * 64 + 16 * cq;
            const u32x4 gt0 = *(const u32x4*)gsrc, gt1 = *(const u32x4*)(gsrc + 8);
            __syncthreads();
            const int il = 16 * w + c;
            const bf16x8 bq0 = ldA(lds + OFF_Q, il, 8 * q, RS), bq1 = ldA(lds + OFF_Q, il, 32 + 8 * q, RS);
#pragma unroll
            for (int jb = 0; jb < 8; ++jb) {
                f32x4 s = {0.f, 0.f, 0.f, 0.f};
                s = MFMA16(ldA(lds + OFF_K, 16 * jb + c, 8 * q, RS), bq0, s);
                s = MFMA16(ldA(lds + OFF_K, 16 * jb + c, 32 + 8 * q, RS), bq1, s);
                const int dj = il - 16 * jb - 4 * q;
                const float e0 = __builtin_amdgcn_exp2f((float)(dj < 0 ? 0 : dj) * l2g);
                float pv[4];
#pragma unroll
                for (int r = 0; r < 4; ++r) pv[r] = (dj - r >= 0) ? s[r] * e0 * gr[r] : 0.f;
                u32x2 v; v.x = pk2_(pv[0], pv[1]); v.y = pk2_(pv[2], pv[3]);
                *(RLAS u32x2*)(lds + OFF_P + (il * PS + 16 * jb + 4 * q) * 2) = v;
            }
            f32x4 a1[4], a2[4];
#pragma unroll
            for (int et = 0; et < 4; ++et) { a1[et] = (f32x4){0.f, 0.f, 0.f, 0.f}; a2[et] = (f32x4){0.f, 0.f, 0.f, 0.f}; }
#pragma unroll
            for (int ks = 0; ks < 4; ++ks) {
                const bf16x8 ap = ldA(lds + OFF_P, il, 32 * ks + 8 * q, PS);
#pragma unroll
                for (int et = 0; et < 4; ++et) a1[et] = MFMA16(ap, ldT(lds + OFF_V, 32 * ks, 16 * et, c, q), a1[et]);
            }
#pragma unroll
            for (int et = 0; et < 4; ++et) { a2[et] = MFMA16(bq0, ldA(lds + OFF_RT, 16 * et + c, 8 * q, RS), a2[et]); a2[et] = MFMA16(bq1, ldA(lds + OFF_RT, 16 * et + c, 32 + 8 * q, RS), a2[et]); }
            float xi[4], sum[4], mu[4], rs[4];
#pragma unroll
            for (int r = 0; r < 4; ++r) { xi[r] = __builtin_amdgcn_exp2f((float)(16 * w + 4 * q + r + 1) * l2g); sum[r] = 0.f; }
#pragma unroll
            for (int et = 0; et < 4; ++et)
#pragma unroll
                for (int r = 0; r < 4; ++r) { a1[et][r] += xi[r] * a2[et][r]; sum[r] += a1[et][r]; }
#pragma unroll
            for (int r = 0; r < 4; ++r) { float s = sum[r]; s += __shfl_xor(s, 1); s += __shfl_xor(s, 2); s += __shfl_xor(s, 4); s += __shfl_xor(s, 8); mu[r] = s * (1.f / 64.f); sum[r] = 0.f; }
#pragma unroll
            for (int et = 0; et < 4; ++et)
#pragma unroll
                for (int r = 0; r < 4; ++r) { const float d = a1[et][r] - mu[r]; a1[et][r] = d; sum[r] += d * d; }
#pragma unroll
            for (int r = 0; r < 4; ++r) { float s = sum[r]; s += __shfl_xor(s, 1); s += __shfl_xor(s, 2); s += __shfl_xor(s, 4); s += __shfl_xor(s, 8); rs[r] = 1.0f / sqrtf(s * (1.f / 64.f) + 1e-6f); }
#pragma unroll
            for (int et = 0; et < 4; ++et)
#pragma unroll
                for (int r = 0; r < 4; ++r) *(RLAS float*)(lds + OFF_P + (16 * w + 4 * q + r) * PS * 2 + (16 * et + c) * 4) = a1[et][r] * rs[r];
            {
                ldsptr src = lds + OFF_P + (16 * w + rowl) * PS * 2 + 64 * cq;
                float gate[16];
                { float t8[8];
                  t8[0] = bf2f_(gt0.x & 0xffffu); t8[1] = bf2f_(gt0.x >> 16); t8[2] = bf2f_(gt0.y & 0xffffu); t8[3] = bf2f_(gt0.y >> 16); t8[4] = bf2f_(gt0.z & 0xffffu); t8[5] = bf2f_(gt0.z >> 16); t8[6] = bf2f_(gt0.w & 0xffffu); t8[7] = bf2f_(gt0.w >> 16);
#pragma unroll
                  for (int j = 0; j < 8; ++j) gate[j] = t8[j];
                  t8[0] = bf2f_(gt1.x & 0xffffu); t8[1] = bf2f_(gt1.x >> 16); t8[2] = bf2f_(gt1.y & 0xffffu); t8[3] = bf2f_(gt1.y >> 16); t8[4] = bf2f_(gt1.z & 0xffffu); t8[5] = bf2f_(gt1.z >> 16); t8[6] = bf2f_(gt1.w & 0xffffu); t8[7] = bf2f_(gt1.w >> 16);
#pragma unroll
                  for (int j = 0; j < 8; ++j) gate[8 + j] = t8[j]; }
                unsigned ow[8];
#pragma unroll
                for (int j = 0; j < 4; ++j) { const f32x4 y = *(const RLAS f32x4*)(src + 16 * j) * gsv[j];
                    ow[2 * j] = pk2_(y[0] * gate[4 * j], y[1] * gate[4 * j + 1]); ow[2 * j + 1] = pk2_(y[2] * gate[4 * j + 2], y[3] * gate[4 * j + 3]); }
                unsigned short* dst = Y + ((size_t)b * SEQL + row0 + 16 * w + rowl) * 1024 + h * 64 + 16 * cq;
                *(u32x4*)dst = (u32x4){ow[0], ow[1], ow[2], ow[3]}; *(u32x4*)(dst + 8) = (u32x4){ow[4], ow[5], ow[6], ow[7]};
            }
            state_update(lds, acc_s, gc, w, c, q);
            __syncthreads();
        }
    }
}
#undef MFMA16
#undef RLAS
}
#define LAS __attribute__((address_space(3)))
#define XB_TMO      128
#define XB_XCNT(j)  (256  + 64 * (j))
#define XB_XSUB(j)  (1280 + 64 * (j))
#define XB_XGEN(j)  (2304 + 64 * (j))
#define XB_TOP      3328
#define XB_TOPGEN   3392
#define XCD_BAR_WORDS 3456
#define XB_SPIN_CAP (1u << 18)

__device__ __forceinline__ unsigned xb_ld(unsigned* p)              { return __hip_atomic_load(p, __ATOMIC_RELAXED, __HIP_MEMORY_SCOPE_AGENT); }
__device__ __forceinline__ unsigned xb_add(unsigned* p, unsigned v) { return __hip_atomic_fetch_add(p, v, __ATOMIC_RELAXED, __HIP_MEMORY_SCOPE_AGENT); }
__device__ __forceinline__ unsigned xb_xcc_id() { return (unsigned)__builtin_amdgcn_s_getreg((3 << 11) | 20) & 0xFu; }
#define XB_SPIN(cond, bar) do { unsigned _sp = 0; while (cond) { __builtin_amdgcn_s_sleep(1); \
    if ((++_sp & 255u) == 0u) { if (xb_ld(&(bar)[XB_TMO])) break; if (_sp > XB_SPIN_CAP) { atomicAdd(&(bar)[XB_TMO], 1u); break; } } } } while (0)

struct XcdBarrier {
    unsigned* bar; unsigned x;
    volatile LAS unsigned* st;
};

__device__ __forceinline__ XcdBarrier xcd_barrier_post(unsigned* bar, volatile LAS unsigned* st) {
    XcdBarrier b; b.bar = bar; b.x = xb_xcc_id(); b.st = st;
    if (threadIdx.x == 0) (void)xb_add(&bar[XB_XCNT(b.x)], 1u);
    return b;
}
__device__ __forceinline__ void xcd_barrier_complete(unsigned* bar, unsigned x, unsigned& nloc, unsigned& nx) {
    const unsigned G = gridDim.x * gridDim.y * gridDim.z;
    unsigned sum, cnt, mine, sp = 0u;
    for (;;) {
        sum = 0u; cnt = 0u; mine = 0u;
#pragma unroll
        for (unsigned j = 0; j < 16; ++j) { const unsigned c = xb_ld(&bar[XB_XCNT(j)]); sum += c; cnt += (c > 0u) ? 1u : 0u; mine = (j == x) ? c : mine; }
        if (sum == G) break;
        __builtin_amdgcn_s_sleep(1);
        if ((++sp & 255u) == 0u) { if (xb_ld(&bar[XB_TMO])) break; if (sp > XB_SPIN_CAP) { atomicAdd(&bar[XB_TMO], 1u); break; } }
    }
    nloc = mine > 0u ? mine : 1u; nx = cnt > 0u ? cnt : 1u;
}

__device__ __forceinline__ void xcd_barrier(const XcdBarrier& b) {
    asm volatile("s_waitcnt vmcnt(0)" ::: "memory");
    __syncthreads();
    if (threadIdx.x == 0) {
        unsigned* bar = b.bar;
        __builtin_amdgcn_s_waitcnt(0);
        unsigned nloc = b.st[0], nx = b.st[1];
        if (nloc == 0u) { xcd_barrier_complete(bar, b.x, nloc, nx); b.st[0] = nloc; b.st[1] = nx; }
        const unsigned old = xb_add(&bar[XB_XSUB(b.x)], 1u);
        const unsigned gen = old / nloc;
        if (old + 1u == (gen + 1u) * nloc) {
            __builtin_amdgcn_fence(__ATOMIC_RELEASE, "agent");
            asm volatile("s_waitcnt vmcnt(0)" ::: "memory");
            const unsigned og = xb_add(&bar[XB_TOP], 1u);
            const unsigned tg = og / nx;
            if (og + 1u == (tg + 1u) * nx) xb_add(&bar[XB_TOPGEN], 1u);
            else XB_SPIN(xb_ld(&bar[XB_TOPGEN]) == tg, bar);
            __builtin_amdgcn_fence(__ATOMIC_ACQUIRE, "agent");
            xb_add(&bar[XB_XGEN(b.x)], 1u);
            asm volatile("s_waitcnt vmcnt(0)" ::: "memory");
        } else {
            XB_SPIN(xb_ld(&bar[XB_XGEN(b.x)]) == gen, bar);
            __builtin_amdgcn_fence(__ATOMIC_ACQUIRE, "agent");
            asm volatile("s_waitcnt vmcnt(0)" ::: "memory");
        }
    }
    __syncthreads();
}
typedef unsigned short bf16;
typedef float f32x4 __attribute__((ext_vector_type(4)));
typedef unsigned u32x4 __attribute__((ext_vector_type(4)));
typedef unsigned u32x2 __attribute__((ext_vector_type(2)));

__device__ __forceinline__ unsigned f2bf(float f) { unsigned u = __builtin_bit_cast(unsigned, f); return (u + 0x7fffu + ((u >> 16) & 1u)) >> 16; }
__device__ __forceinline__ float bf2f(unsigned h) { return __builtin_bit_cast(float, h << 16); }
__device__ __forceinline__ unsigned pk2(float lo, float hi) { return f2bf(lo) | (f2bf(hi) << 16); }
__device__ __forceinline__ float silu_f(float v) { return v / (1.f + expf(-v)); }
__device__ __forceinline__ float wave_sum(float v) {
#pragma unroll
    for (int o = 1; o < 64; o <<= 1) v += __shfl_xor(v, o);
    return v;
}
__device__ __forceinline__ void unpack8(u32x4 v, float (&a)[8]) {
    a[0] = bf2f(v.x & 0xffffu); a[1] = bf2f(v.x >> 16); a[2] = bf2f(v.y & 0xffffu); a[3] = bf2f(v.y >> 16);
    a[4] = bf2f(v.z & 0xffffu); a[5] = bf2f(v.z >> 16); a[6] = bf2f(v.w & 0xffffu); a[7] = bf2f(v.w >> 16);
}

constexpr size_t MiB = 1u << 20;
constexpr size_t WS_CTL = 0, CTL_ZERO_BYTES = 65536;
constexpr size_t WS_MOD = 1 * MiB;
constexpr size_t WS_BIAS = 1 * MiB + 512 * 1024;
constexpr size_t WS_ROPE = 2 * MiB;
constexpr size_t WS_TAB = 3 * MiB;
constexpr size_t WS_SS = 3 * MiB + 65536;
constexpr size_t WS_W1T = 4 * MiB;
constexpr size_t WS_W2T = 15 * MiB;
constexpr size_t WS_WINT = 21 * MiB;
constexpr size_t WS_WOT = 28 * MiB;
constexpr size_t WS_W3T = 30 * MiB;
constexpr size_t WS_W4T = 41 * MiB;
constexpr size_t WS_GS = 48 * MiB;
constexpr size_t WS_H = 96 * MiB;
constexpr size_t WS_OA = 160 * MiB;
constexpr size_t WS_ACT = 224 * MiB;
constexpr size_t WS_PROJ = WS_ACT;
constexpr size_t WS_Y = 448 * MiB;
constexpr size_t WS_END = 512 * MiB;

struct Params { const float* in[21]; float* out; unsigned char* ws; };
enum { I_X = 0, I_C, I_WADA, I_BADA, I_NF1, I_W1IN, I_W1OUT, I_NMIX, I_WIN, I_LQ1, I_LK1, I_LQ2, I_LK2, I_SUBLN, I_GS, I_WOUT, I_NF2, I_W2IN, I_W2OUT, I_RELB, I_NFIN };

constexpr int NTHREADS = 512, NWAVES = 8;
constexpr int LDS_BYTES = 147456;
constexpr int LDS_CTL = LDS_BYTES - 1024;
constexpr int LDS_MISC_OFF = LDS_CTL + 320;

template <int MAP> __device__ __forceinline__ int physrow32(int n0) {
    if (MAP == 1) { return n0 < FF ? 256 * (n0 / 128) + (n0 % 128) : 256 * ((n0 - FF) / 128) + 128 + ((n0 - FF) % 128); }
    if (MAP == 2) { if (n0 < 1024) { const int pn = n0 >> 8, w = n0 & 255, head = w >> 6, half = (w >> 5) & 1; return 256 * pn + half * 128 + head * 32; } return n0; }
    return n0;
}
template <int MAP> __device__ __forceinline__ void transpose_item(const float* W, int K, int N, bf16* WT, LAS float* scr, int item, int lane) {
    const int nblk = N / 32, kb = item / nblk, nb = item % nblk, k0 = 64 * kb, n0 = 32 * nb;
#pragma unroll 8
    for (int i = 0; i < 32; ++i) { const int kk = 2 * i + (lane >> 5); scr[kk * 33 + (lane & 31)] = W[(size_t)(k0 + kk) * N + n0 + (lane & 31)]; }
    asm volatile("s_waitcnt lgkmcnt(0)" ::: "memory");
    const int c = lane & 7; const int prow = physrow32<MAP>(n0);
#pragma unroll
    for (int j = 0; j < 4; ++j) { const int n = (lane >> 3) + 8 * j; const LAS float* s = scr + (8 * c) * 33 + n;
        u32x4 o; o.x = pk2(s[0 * 33], s[1 * 33]); o.y = pk2(s[2 * 33], s[3 * 33]); o.z = pk2(s[4 * 33], s[5 * 33]); o.w = pk2(s[6 * 33], s[7 * 33]);
        *(u32x4*)(WT + (size_t)(prow + n) * K + k0 + 8 * c) = o; }
    asm volatile("s_waitcnt lgkmcnt(0)" ::: "memory");
}

__device__ __forceinline__ void norm_rows(const float* X, const float* g, const float* mod, int shi, int sci, bf16* H, long gwave, long nwaves, int lane) {
    constexpr int NB = 4;
    for (long row0 = gwave * NB; row0 < T; row0 += nwaves * NB) {
        f32x4 v[NB][4]; float ss[NB];
#pragma unroll
        for (int r = 0; r < NB; ++r) { const f32x4* xr = (const f32x4*)(X + (size_t)(row0 + r) * DM) + lane;
#pragma unroll
            for (int j = 0; j < 4; ++j) v[r][j] = xr[64 * j]; }
#pragma unroll
        for (int r = 0; r < NB; ++r) { float s = 0.f;
#pragma unroll
            for (int j = 0; j < 4; ++j) s += (v[r][j].x * v[r][j].x + v[r][j].y * v[r][j].y) + (v[r][j].z * v[r][j].z + v[r][j].w * v[r][j].w);
            ss[r] = 1.0f / sqrtf(wave_sum(s) * (1.f / DM) + EPS); }
        const int b = (int)(row0 / SEQ);
#pragma unroll
        for (int j = 0; j < 4; ++j) {
            const int col = 256 * j + 4 * lane;
            const f32x4 gg = *(const f32x4*)(g + col);
            const f32x4 sc = *(const f32x4*)(mod + (size_t)b * NMODC + sci * DM + col);
            const f32x4 sh = *(const f32x4*)(mod + (size_t)b * NMODC + shi * DM + col);
            const f32x4 ab = gg * (sc + 1.0f);
#pragma unroll
            for (int r = 0; r < NB; ++r) { const f32x4 o = v[r][j] * ss[r] * ab + sh; u32x2 w; w.x = pk2(o.x, o.y); w.y = pk2(o.z, o.w); ((u32x2*)(H + (size_t)(row0 + r) * DM) + lane)[64 * j] = w; }
        }
    }
}

__device__ __forceinline__ int t5_bucket(int n) {
    if (n < 16) return n;
    if (n >= 113) return 31;
    int large = 16 + (int)(logf((float)n / 16.0f) / 2.0794415416798357f * 16.0f);
    return large < 31 ? large : 31;
}

__device__ __forceinline__ void retention_simple(const bf16* PROJ, const float* gs, bf16* Y, long gtid, long gthreads) {
    for (long it = gtid; it < (long)BATCH * 8 * SEQ; it += gthreads) {
        const int i = (int)(it % SEQ), h = (int)((it / SEQ) % 8), b = (int)(it / (SEQ * 8));
        const float l2g = log2f(1.0f - exp2f(-5.0f - (float)h));
        const bf16* base = PROJ + (size_t)b * SEQ * NIN;
        float q[64], o[64];
#pragma unroll
        for (int d8 = 0; d8 < 8; ++d8) { float a[8]; unpack8(*(const u32x4*)(base + (size_t)i * NIN + h * 64 + d8 * 8), a);
#pragma unroll
            for (int j = 0; j < 8; ++j) q[d8 * 8 + j] = a[j]; }
#pragma unroll
        for (int e = 0; e < 64; ++e) o[e] = 0.f;
        for (int t = 0; t <= i; ++t) {
            const bf16* kr = base + (size_t)t * NIN + 512 + h * 64; const bf16* vr = base + (size_t)t * NIN + 1024 + h * 64;
            float s = 0.f;
#pragma unroll
            for (int d8 = 0; d8 < 8; ++d8) { float a[8]; unpack8(*(const u32x4*)(kr + d8 * 8), a);
#pragma unroll
                for (int j = 0; j < 8; ++j) s += q[d8 * 8 + j] * a[j]; }
            s *= exp2f((float)(i - t) * l2g);
#pragma unroll
            for (int d8 = 0; d8 < 8; ++d8) { float a[8]; unpack8(*(const u32x4*)(vr + d8 * 8), a);
#pragma unroll
                for (int j = 0; j < 8; ++j) o[d8 * 8 + j] += s * a[j]; }
        }
        float mu = 0.f;
#pragma unroll
        for (int e = 0; e < 64; ++e) mu += o[e];
        mu *= (1.f / 64.f); float var = 0.f;
#pragma unroll
        for (int e = 0; e < 64; ++e) { const float d = o[e] - mu; var += d * d; }
        const float rs = 1.0f / sqrtf(var * (1.f / 64.f) + EPS);
        const size_t row = (size_t)b * SEQ + i;
#pragma unroll
        for (int e = 0; e < 64; ++e) {
            const float g = bf2f(PROJ[row * NIN + 1536 + h * 64 + e]);
            Y[row * DM + h * 64 + e] = (bf16)f2bf((o[e] - mu) * rs * g * gs[h * 64 + e]);
        }
    }
}
__device__ __forceinline__ void diffattn_simple(const bf16* PROJ, const float* relb, bf16* OA, long gtid, long gthreads) {
    for (long it = gtid; it < (long)BATCH * 32 * SEQ; it += gthreads) {
        const int qi = (int)(it % SEQ); const int rest = (int)(it / SEQ);
        const int vq = rest & 3, m = (rest >> 2) & 1, h = (rest >> 3) & 3, b = rest >> 5;
        const bf16* base = PROJ + (size_t)b * SEQ * NIN;
        float q[64], o[32];
#pragma unroll
        for (int d8 = 0; d8 < 8; ++d8) { float a[8]; unpack8(*(const u32x4*)(base + (size_t)qi * NIN + 2048 + h * 128 + m * 64 + d8 * 8), a);
#pragma unroll
            for (int j = 0; j < 8; ++j) q[d8 * 8 + j] = a[j]; }
#pragma unroll
        for (int e = 0; e < 32; ++e) o[e] = 0.f;
        float mrun = -1e30f, l = 0.f;
        for (int t = 0; t <= qi; ++t) {
            const bf16* kr = base + (size_t)t * NIN + 2560 + h * 128 + m * 64; const bf16* vr = base + (size_t)t * NIN + 3072 + h * 128 + vq * 32;
            float s = 0.f;
#pragma unroll
            for (int d8 = 0; d8 < 8; ++d8) { float a[8]; unpack8(*(const u32x4*)(kr + d8 * 8), a);
#pragma unroll
                for (int j = 0; j < 8; ++j) s += q[d8 * 8 + j] * a[j]; }
            s += relb[t5_bucket(qi - t) * 4 + h] * LOG2E;
            if (s > mrun) { const float f = exp2f(mrun - s); l *= f;
#pragma unroll
                for (int e = 0; e < 32; ++e) o[e] *= f;
                mrun = s; }
            const float pe = exp2f(s - mrun); l += pe;
#pragma unroll
            for (int d8 = 0; d8 < 4; ++d8) { float a[8]; unpack8(*(const u32x4*)(vr + d8 * 8), a);
#pragma unroll
                for (int j = 0; j < 8; ++j) o[d8 * 8 + j] += pe * a[j]; }
        }
        const float li = 1.0f / l; const size_t row = (size_t)b * SEQ + qi;
        bf16* op = OA + row * DM + ((h * 2 + m) * 2 + (vq >> 1)) * 64 + (vq & 1) * 32;
#pragma unroll
        for (int e = 0; e < 32; ++e) op[e] = (bf16)f2bf(o[e] * li);
    }
}
__device__ __forceinline__ void combine_rows(const Params& p, const bf16* OA, bf16* Y, long gwave, long nwaves, int lane) {
    const float s1 = wave_sum(p.in[I_LQ1][lane] * p.in[I_LK1][lane]), s2 = wave_sum(p.in[I_LQ2][lane] * p.in[I_LK2][lane]);
    const float lam = expf(s1) - expf(s2) + 0.2f;
    const int h = lane >> 4, e0 = (lane & 15) * 8, half = e0 >> 6, ee = e0 & 63;
    float sg[8];
#pragma unroll
    for (int j = 0; j < 8; ++j) sg[j] = p.in[I_SUBLN][e0 + j] * 0.8f * p.in[I_GS][512 + h * 128 + e0 + j];
    constexpr int NB = 4;
    for (long row0 = gwave * NB; row0 < T; row0 += nwaves * NB) {
        u32x4 q0[NB], q1[NB];
#pragma unroll
        for (int r = 0; r < NB; ++r) { q0[r] = *(const u32x4*)(OA + (size_t)(row0 + r) * DM + ((h * 2 + 0) * 2 + half) * 64 + ee); q1[r] = *(const u32x4*)(OA + (size_t)(row0 + r) * DM + ((h * 2 + 1) * 2 + half) * 64 + ee); }
#pragma unroll
        for (int r = 0; r < NB; ++r) {
            float a0[8], a1[8], d[8]; unpack8(q0[r], a0); unpack8(q1[r], a1);
            float ss = 0.f;
#pragma unroll
            for (int j = 0; j < 8; ++j) { d[j] = a0[j] - lam * a1[j]; ss += d[j] * d[j]; }
            ss += __shfl_xor(ss, 1); ss += __shfl_xor(ss, 2); ss += __shfl_xor(ss, 4); ss += __shfl_xor(ss, 8);
            const float rs = 1.0f / sqrtf(ss * (1.f / 128.f) + EPS);
            unsigned w[4];
#pragma unroll
            for (int j = 0; j < 8; j += 2) w[j >> 1] = pk2(d[j] * rs * sg[j], d[j + 1] * rs * sg[j + 1]);
            *(u32x4*)(Y + (size_t)(row0 + r) * DM + 512 + h * 128 + e0) = (u32x4){w[0], w[1], w[2], w[3]};
        }
    }
}

__device__ __forceinline__ void bias_rows(const bf16* WT, int nrows, const float* mod, int shi, float* BIAS, long gwave, long nwaves, int lane) {
    float sh[8][16];
#pragma unroll
    for (int b = 0; b < 8; ++b)
#pragma unroll
        for (int j = 0; j < 2; ++j) { const float* sp = mod + (size_t)b * NMODC + shi * DM + j * 512 + 8 * lane; const f32x4 a = *(const f32x4*)sp, c = *(const f32x4*)(sp + 4);
            sh[b][8 * j + 0] = a.x; sh[b][8 * j + 1] = a.y; sh[b][8 * j + 2] = a.z; sh[b][8 * j + 3] = a.w; sh[b][8 * j + 4] = c.x; sh[b][8 * j + 5] = c.y; sh[b][8 * j + 6] = c.z; sh[b][8 * j + 7] = c.w; }
    for (long r = gwave; r < nrows; r += nwaves) {
        float w0[8], w1[8];
        unpack8(*(const u32x4*)(WT + (size_t)r * DM + 8 * lane), w0); unpack8(*(const u32x4*)(WT + (size_t)r * DM + 512 + 8 * lane), w1);
#pragma unroll
        for (int b = 0; b < 8; ++b) { float s = 0.f;
#pragma unroll
            for (int j = 0; j < 8; ++j) s += sh[b][j] * w0[j] + sh[b][8 + j] * w1[j];
            s = wave_sum(s); if (lane == b) BIAS[(size_t)b * nrows + r] = s; }
    }
}

#if defined(PROBE_A)
#define SEAM(k) do { if (blockIdx.x == 0 && threadIdx.x == 0) { ((volatile LAS unsigned long long*)(ldsp + LDS_CTL + 512))[k] = __builtin_amdgcn_s_memrealtime(); \
        if ((k) == 10) { volatile LAS unsigned long long* ts_ = (volatile LAS unsigned long long*)(ldsp + LDS_CTL + 512); \
            const float ua = (float)(ts_[PROBE_A + 1] - ts_[PROBE_A]) * 0.01f, ub = (float)(ts_[PROBE_B + 1] - ts_[PROBE_B]) * 0.01f; \
            ((float*)(ws + WS_TAB))[1024] = sqrtf(ua * 1e-6f); ((float*)(ws + WS_TAB))[1025] = 0.0f * ub; } } \
    xcd_barrier(bar); } while (0)
#else
#define SEAM(k) xcd_barrier(bar)
#endif
__global__ void __launch_bounds__(NTHREADS, 2) fwd_mega(Params p) {
    extern __shared__ __attribute__((aligned(16))) unsigned char lds[];
#define PHASE_IDS int tid_l = threadIdx.x; asm volatile("" : "+v"(tid_l)); const int tid = tid_l, lane = tid & 63, wave = __builtin_amdgcn_readfirstlane(tid >> 6); \
    const long gtid = (long)blockIdx.x * NTHREADS + tid, gthreads = (long)gridDim.x * NTHREADS; \
    const long gwave = (long)blockIdx.x * NWAVES + wave, nwaves = (long)gridDim.x * NWAVES; (void)lane; (void)gtid; (void)gthreads; (void)gwave; (void)nwaves;
    unsigned char* ws = p.ws;
    float* MOD = (float*)(ws + WS_MOD);
    float* ROPEC = (float*)(ws + WS_ROPE); float* ROPES = ROPEC + SEQ * 32;
    float* TAB = (float*)(ws + WS_TAB); float* CFAR = TAB + 4 * 128;
    float* SSM = (float*)(ws + WS_SS); float* SS2 = SSM + T; float* BIASM = (float*)(ws + WS_BIAS); float* BIAS2 = BIASM + 8 * NIN;
    bf16* H = (bf16*)(ws + WS_H); bf16* Y = (bf16*)(ws + WS_Y); bf16* OA = (bf16*)(ws + WS_OA);
    bf16* ACT = (bf16*)(ws + WS_ACT); bf16* PROJ = (bf16*)(ws + WS_PROJ);
    bf16 *W1T = (bf16*)(ws + WS_W1T), *W2T = (bf16*)(ws + WS_W2T), *WINT = (bf16*)(ws + WS_WINT), *WOT = (bf16*)(ws + WS_WOT), *W3T = (bf16*)(ws + WS_W3T), *W4T = (bf16*)(ws + WS_W4T);
    const float* x = p.in[I_X]; float* X = p.out;
    PG8_LAS unsigned char* ldsp = (PG8_LAS unsigned char*)lds;
    for (int u = threadIdx.x; u < (LDS_BYTES - LDS_CTL) / 4; u += NTHREADS) ((LAS unsigned*)(ldsp + LDS_CTL))[u] = 0u;
    __syncthreads();
#if defined(PROBE_A)
    if (blockIdx.x == 0 && threadIdx.x == 0) ((volatile LAS unsigned long long*)(ldsp + LDS_CTL + 512))[0] = __builtin_amdgcn_s_memrealtime();
#endif
    const XcdBarrier bar = xcd_barrier_post((unsigned*)(ws + WS_CTL) + 1024, (volatile LAS unsigned*)(ldsp + LDS_MISC_OFF) + 8);

    {
        PHASE_IDS
        float* sc = (float*)lds;
        float* red = sc + 8 * DM;
        if (blockIdx.x < NMODC / 64) {
            for (int i = tid; i < 8 * DM; i += NTHREADS) sc[i] = silu_f(p.in[I_C][i]);
            __syncthreads();
            const int kg = tid >> 6, cg_ = tid & 63; constexpr int klen = DM / 8;
            for (int item = blockIdx.x; item < NMODC / 64; item += gridDim.x) {
                const int n = item * 64 + cg_;
                float acc[8];
#pragma unroll
                for (int b = 0; b < 8; ++b) acc[b] = 0.f;
                const float* w = p.in[I_WADA] + (size_t)(kg * klen) * NMODC + n;
#pragma unroll 4
                for (int k = 0; k < klen; ++k) {
                    const float wv = w[(size_t)k * NMODC];
#pragma unroll
                    for (int b = 0; b < 8; ++b) acc[b] += sc[b * DM + kg * klen + k] * wv;
                }
#pragma unroll
                for (int b = 0; b < 8; ++b) red[(kg * 8 + b) * 64 + cg_] = acc[b];
                __syncthreads();
                { const int b = tid >> 6, c = tid & 63; float s = 0.f;
#pragma unroll
                  for (int g2 = 0; g2 < 8; ++g2) s += red[(g2 * 8 + b) * 64 + c];
                  MOD[(size_t)b * NMODC + item * 64 + c] = s + p.in[I_BADA][item * 64 + c]; }
                __syncthreads();
            }
        }
        for (long i = gtid; i < 2L * T; i += gthreads) SSM[i] = 0.f;
        for (long i = gtid; i < (long)SEQ * 32; i += gthreads) {
            const int pos = (int)(i >> 5), j = (int)(i & 31);
            const float inv = powf(10000.0f, -(float)(2 * j) / 64.0f);
            const float ang = (float)pos * inv;
            ROPEC[i] = cosf(ang); ROPES[i] = sinf(ang);
        }
        if (blockIdx.x == gridDim.x - 1) {
            const int h = tid >> 7, n = tid & 127; const float far = p.in[I_RELB][31 * 4 + h];
            TAB[h * 128 + n] = (p.in[I_RELB][t5_bucket(n) * 4 + h] - far) * LOG2E;
            if (tid < 4) CFAR[tid] = p.in[I_RELB][31 * 4 + tid] * LOG2E;
        }
        __syncthreads();
        LAS float* scr = (LAS float*)(ldsp + wave * 16384);
        constexpr int I_A = (DM / 64) * (2 * FF / 32), I_B = (FF / 64) * (DM / 32), I_C2 = (DM / 64) * (NIN / 32), I_D = (DM / 64) * (DM / 32);
        constexpr int NITEMS = 2 * I_A + 2 * I_B + I_C2 + I_D;
        for (int it = (int)gwave; it < NITEMS; it += (int)nwaves) {
            int r = it;
            if (r < I_A) { transpose_item<1>(p.in[I_W1IN], DM, 2 * FF, W1T, scr, r, lane); continue; } r -= I_A;
            if (r < I_A) { transpose_item<1>(p.in[I_W2IN], DM, 2 * FF, W3T, scr, r, lane); continue; } r -= I_A;
            if (r < I_B) { transpose_item<0>(p.in[I_W1OUT], FF, DM, W2T, scr, r, lane); continue; } r -= I_B;
            if (r < I_B) { transpose_item<0>(p.in[I_W2OUT], FF, DM, W4T, scr, r, lane); continue; } r -= I_B;
            if (r < I_C2) { transpose_item<2>(p.in[I_WIN], DM, NIN, WINT, scr, r, lane); continue; } r -= I_C2;
            transpose_item<0>(p.in[I_WOUT], DM, DM, WOT, scr, r, lane);
        }
    }
    SEAM(1);
    { PHASE_IDS norm_rows(x, p.in[I_NF1], MOD, 0, 1, H, gwave, nwaves, lane); }
    { PHASE_IDS bias_rows(WINT, NIN, MOD, 3, BIASM, gwave, nwaves, lane); }
    { PHASE_IDS bias_rows(W3T, 2 * FF, MOD, 6, BIAS2, gwave, nwaves, lane); }
    SEAM(2);
    { pg8::Gemm g{H, W1T, T, 2 * FF, DM}; pg8::StaticOrder S; S.init(T, 2 * FF, (int)gridDim.x, (int)blockIdx.x); pg8::EpiSwiglu<false> E{ACT, FF, nullptr, nullptr};
      pg8::gemm_phase<pg8::EpiSwiglu<false>, pg8::StaticOrder, true, true>(ldsp, g, S, E); }
    SEAM(3);
    { pg8::Gemm g{ACT, W2T, T, DM, FF}; pg8::StaticOrder S; S.init(T, DM, (int)gridDim.x, (int)blockIdx.x); pg8::EpiResid<true> E{x, X, MOD + 2 * DM, p.in[I_NMIX], MOD + 4 * DM, H, SSM, 0.5f};
      pg8::gemm_phase<pg8::EpiResid<true>, pg8::StaticOrder, true, true>(ldsp, g, S, E); }
    SEAM(4);
    { pg8::Gemm g{H, WINT, T, NIN, DM}; pg8::StaticOrder S; S.init(T, NIN, (int)gridDim.x, (int)blockIdx.x); pg8::EpiProj E{PROJ, ROPEC, ROPES, C2, SSM, BIASM};
      pg8::gemm_phase<pg8::EpiProj, pg8::StaticOrder, true, true>(ldsp, g, S, E); }
    SEAM(5);
    attn_body::attn_phase<8>((char*)lds, (const attn_body::bf16*)PROJ, (attn_body::bf16*)OA, TAB, CFAR, (int)gridDim.x, (int)blockIdx.x);
    ret::phase_a(lds, PROJ, (ret::f32x4*)(ws + WS_GS), (int)gridDim.x, (int)blockIdx.x);
    SEAM(6);
    ret::phase_b(lds, PROJ, (const ret::f32x4*)(ws + WS_GS), p.in[I_GS], Y, (int)gridDim.x, (int)blockIdx.x);
    { PHASE_IDS combine_rows(p, OA, Y, gwave, nwaves, lane); }
    SEAM(7);
    { pg8::Gemm g{Y, WOT, T, DM, DM}; pg8::StaticOrder S; S.init(T, DM, (int)gridDim.x, (int)blockIdx.x); pg8::EpiResid<true> E{X, X, MOD + 5 * DM, p.in[I_NF2], MOD + 7 * DM, H, SS2, 1.0f};
      pg8::gemm_phase<pg8::EpiResid<true>, pg8::StaticOrder, true, true>(ldsp, g, S, E); }
    SEAM(8);
    { pg8::Gemm g{H, W3T, T, 2 * FF, DM}; pg8::StaticOrder S; S.init(T, 2 * FF, (int)gridDim.x, (int)blockIdx.x); pg8::EpiSwiglu<true> E{ACT, FF, SS2, BIAS2};
      pg8::gemm_phase<pg8::EpiSwiglu<true>, pg8::StaticOrder, true, true>(ldsp, g, S, E); }
    SEAM(9);
    { pg8::Gemm g{ACT, W4T, T, DM, FF}; pg8::StaticOrder S; S.init(T, DM, (int)gridDim.x, (int)blockIdx.x); pg8::EpiResid<false> E{X, X, MOD + 8 * DM, nullptr, nullptr, nullptr, nullptr, 0.5f};
      pg8::gemm_phase<pg8::EpiResid<false>, pg8::StaticOrder, true, true>(ldsp, g, S, E); }
    SEAM(10);
    { PHASE_IDS
    constexpr int NB = 4;
    f32x4 gf[4];
#pragma unroll
    for (int j = 0; j < 4; ++j) gf[j] = *(const f32x4*)(p.in[I_NFIN] + 256 * j + 4 * lane);
#if defined(PROBE_A)
    const float pscale = 1.0f + ((const float*)(ws + WS_TAB))[1024];
#pragma unroll
    for (int j = 0; j < 4; ++j) gf[j] = gf[j] * pscale;
#endif
    for (long row0 = gwave * NB; row0 < T; row0 += nwaves * NB) {
        f32x4 v[NB][4];
#pragma unroll
        for (int r = 0; r < NB; ++r) { const f32x4* xr = (const f32x4*)(X + (size_t)(row0 + r) * DM) + lane;
#pragma unroll
            for (int j = 0; j < 4; ++j) v[r][j] = xr[64 * j]; }
#pragma unroll
        for (int r = 0; r < NB; ++r) { float s = 0.f;
#pragma unroll
            for (int j = 0; j < 4; ++j) s += (v[r][j].x * v[r][j].x + v[r][j].y * v[r][j].y) + (v[r][j].z * v[r][j].z + v[r][j].w * v[r][j].w);
            const float rinv = 1.0f / sqrtf(wave_sum(s) * (1.f / DM) + EPS);
            f32x4* xw = (f32x4*)(X + (size_t)(row0 + r) * DM) + lane;
#pragma unroll
            for (int j = 0; j < 4; ++j) xw[64 * j] = v[r][j] * rinv * gf[j]; }
    } }
}

extern "C" void kernel_launch(void* const* d_in, const int* in_sizes, int n_in, void* d_out, int out_size, void* d_ws, size_t ws_size, hipStream_t stream) {
    static int grid = 0;
    if (grid == 0) {
        if (n_in != 21 || out_size != T * DM || ws_size < WS_END) { fprintf(stderr, "kernel_launch: unexpected shapes (n_in %d out %d ws %zu)\n", n_in, out_size, ws_size); grid = -1; return; }
        int dev = 0, cus = 0, per_cu = 0;
        if (hipGetDevice(&dev) != hipSuccess || hipDeviceGetAttribute(&cus, hipDeviceAttributeMultiprocessorCount, dev) != hipSuccess) { grid = -1; return; }
        if (hipFuncSetAttribute((const void*)fwd_mega, hipFuncAttributeMaxDynamicSharedMemorySize, LDS_BYTES) != hipSuccess) { fprintf(stderr, "kernel_launch: hipFuncSetAttribute failed\n"); grid = -1; return; }
        if (hipOccupancyMaxActiveBlocksPerMultiprocessor(&per_cu, (const void*)fwd_mega, NTHREADS, LDS_BYTES) != hipSuccess || per_cu < 1) { fprintf(stderr, "kernel_launch: occupancy query says %d blocks/CU\n", per_cu); (void)hipGetLastError(); }
        grid = cus;
        if (grid != 256) { fprintf(stderr, "kernel_launch: built for a 256-CU device, found %d CUs\n", cus); grid = -1; return; }
        fprintf(stderr, "kernel_launch: %d CUs, occupancy %d\n", cus, per_cu);
    }
    if (grid < 0) return;
    if (hipMemsetAsync((char*)d_ws + WS_CTL, 0, CTL_ZERO_BYTES, stream) != hipSuccess) { fprintf(stderr, "kernel_launch: hipMemsetAsync failed\n"); return; }
    Params p{};
    for (int i = 0; i < 21; ++i) p.in[i] = (const float*)d_in[i];
    p.out = (float*)d_out; p.ws = (unsigned char*)d_ws;
    void* args[] = {&p};
    hipError_t e = hipLaunchCooperativeKernel((const void*)fwd_mega, dim3(grid), dim3(NTHREADS), args, LDS_BYTES, stream);
    if (e != hipSuccess) fprintf(stderr, "cooperative launch failed: %s (grid %d)\n", hipGetErrorString(e), grid);
}
```

```cpp
#include <hip/hip_runtime.h>
#include <hip/hip_cooperative_groups.h>
#include <cstdio>
#include <cstdint>
namespace cg = cooperative_groups;

constexpr int BATCH = 8, SEQ = 4096, DM = 1024, T = BATCH * SEQ, FF = 2816, NIN = 3584, NMODC = 9 * DM;
constexpr float EPS = 1e-6f;
constexpr float LOG2E = 1.4426950408889634f;
constexpr float C2 = 0.125f * LOG2E;
namespace pg8 {
#define PG8_LAS __attribute__((address_space(3)))
typedef unsigned short bf16_t;
typedef short bf16x8 __attribute__((ext_vector_type(8)));
typedef float f32x4 __attribute__((ext_vector_type(4)));
typedef unsigned u32x4 __attribute__((ext_vector_type(4)));
constexpr int BM = 256, BK = 64, HALF = 128, HTB = HALF * BK * 2  , STAGE_BYTES = 8 * HTB, NXCD = 8, WGM = 8;

__host__ __device__ __forceinline__ int lds_byte(int r, int c) { const int st = (r >> 4) * 2 + (c >> 5), rr = r & 15, cc = c & 31, ob = rr * 64 + cc * 2; return st * 1024 + (ob ^ (((ob >> 9) & 1) << 5)); }
__host__ __device__ __forceinline__ void stage_rc(int b, int& R, int& C) { const int st = b / 1024, sb = b % 1024, swz = sb ^ (((sb >> 9) & 1) << 5); R = (st >> 1) * 16 + swz / 64; C = (st & 1) * 32 + (swz % 64) / 2; }
__host__ __device__ __forceinline__ int perm32(int rho) { const int n = rho >> 4, i = rho & 15; return 8 * (i >> 2) + 4 * n + (i & 3); }

struct Unit { int pm, pn; };
struct Gemm { const bf16_t* A; const bf16_t* Bt; int M, N, K; };

struct StaticOrder {
    int nM, nN, nwg, G, c;
    __host__ __device__ void init(int M, int N, int G_, int c_) { nM = M / BM; nN = N / BM; nwg = nM * nN; G = G_; c = c_; }
    __host__ __device__ bool next(int i, Unit& u) const {
        const long L = (long)i * G + c; if (L >= nwg) return false;
        int wgid = (int)L; { const int q = nwg / NXCD, r = nwg % NXCD, xcd = wgid % NXCD, off = wgid / NXCD; wgid = (xcd < r ? xcd * (q + 1) : r * (q + 1) + (xcd - r) * q) + off; }
        const int nig = WGM * nN, gid = wgid / nig, fm = gid * WGM, gsz = (nM - fm) < WGM ? (nM - fm) : WGM;
        u.pm = fm + ((wgid % nig) % gsz); u.pn = (wgid % nig) / gsz; return true;
    }
    __device__ __forceinline__ void a_ready(const Unit&) const {}
    __device__ __forceinline__ void done(const Unit&) const {}
};
__device__ __forceinline__ unsigned cvt_pk_bf16(float lo, float hi) { unsigned r; asm volatile("v_cvt_pk_bf16_f32 %0, %1, %2" : "=v"(r) : "v"(lo), "v"(hi)); return r; }
typedef float f32x2 __attribute__((ext_vector_type(2)));
__device__ __forceinline__ float fast_silu(float v) { return v * __builtin_amdgcn_rcpf(1.0f + __builtin_amdgcn_exp2f(-1.4426950408889634f * v)); }
template <bool DEFER> struct EpiSwiglu {
    static constexpr bool PERM = true, AFTER_DRAIN = false;
    bf16_t* O; int ldc; const float* ss; const float* bias;
    __device__ __forceinline__ void operator()(const f32x4 (&acc)[2][2][4][2], const Unit& u, int wr, int wc, int fr, int fq) const {
        const int row0 = u.pm * BM + wr * 64 + fr, col0 = u.pn * HALF + wc * 32 + 8 * fq;
        f32x4 bg0, bg1, bu0, bu1;
        if (DEFER) { const float* bp = bias + (size_t)(u.pm >> 4) * 5632 + u.pn * BM + wc * 32 + 8 * fq;
            bg0 = *(const f32x4*)bp; bg1 = *(const f32x4*)(bp + 4); bu0 = *(const f32x4*)(bp + HALF); bu1 = *(const f32x4*)(bp + HALF + 4); }
#pragma unroll
        for (int ai = 0; ai < 2; ++ai)
#pragma unroll
            for (int m = 0; m < 4; ++m) {
                bf16_t* rowp = O + (size_t)(row0 + ai * HALF + m * 16) * ldc + col0;
                f32x4 g0 = acc[ai][0][m][0], g1 = acc[ai][0][m][1], u0 = acc[ai][1][m][0], u1 = acc[ai][1][m][1];
                if (DEFER) { const float ri = __builtin_amdgcn_rsqf(ss[row0 + ai * HALF + m * 16] * (1.0f / 1024.0f) + 1e-6f);
                    g0 = g0 * ri + bg0; g1 = g1 * ri + bg1; u0 = u0 * ri + bu0; u1 = u1 * ri + bu1; }
                f32x4 v0, v1;
#pragma unroll
                for (int e = 0; e < 4; ++e) { v0[e] = fast_silu(g0[e]) * u0[e]; v1[e] = fast_silu(g1[e]) * u1[e]; }
                u32x4 w; w.x = cvt_pk_bf16(v0[0], v0[1]); w.y = cvt_pk_bf16(v0[2], v0[3]); w.z = cvt_pk_bf16(v1[0], v1[1]); w.w = cvt_pk_bf16(v1[2], v1[3]);
                *(u32x4*)rowp = w;
            }
    }
};
template <bool NEXT> struct EpiResid {
    static constexpr bool PERM = false, AFTER_DRAIN = false;
    const float* base; float* out; const float* gate; const float* ng; const float* nsc; bf16_t* hn; float* ssq; float scale;
    __device__ __forceinline__ void operator()(const f32x4 (&acc)[2][2][4][2], const Unit& u, int wr, int wc, int fr, int fq) const {
        const int col0 = u.pn * BM + wc * 32 + 4 * fq, b = u.pm >> 4;
        f32x4 gv[2][2], ab[2][2];
#pragma unroll
        for (int bj = 0; bj < 2; ++bj)
#pragma unroll
            for (int n = 0; n < 2; ++n) { gv[bj][n] = *(const f32x4*)(gate + (size_t)b * 9216 + col0 + bj * HALF + n * 16) * scale;
                if (NEXT) ab[bj][n] = *(const f32x4*)(ng + col0 + bj * HALF + n * 16) * (*(const f32x4*)(nsc + (size_t)b * 9216 + col0 + bj * HALF + n * 16) + 1.0f); }
#pragma unroll
        for (int ai = 0; ai < 2; ++ai)
#pragma unroll
            for (int m = 0; m < 4; ++m) {
                const int row = u.pm * BM + ai * HALF + wr * 64 + m * 16 + fr;
                const size_t off = (size_t)row * 1024 + col0; float sq = 0.f;
#pragma unroll
                for (int bj = 0; bj < 2; ++bj)
#pragma unroll
                    for (int n = 0; n < 2; ++n) { const f32x4 bs = *(const f32x4*)(base + off + bj * HALF + n * 16); const f32x4 o = bs + gv[bj][n] * acc[ai][bj][m][n]; *(f32x4*)(out + off + bj * HALF + n * 16) = o;
                        if (NEXT) { sq += (o[0] * o[0] + o[1] * o[1]) + (o[2] * o[2] + o[3] * o[3]); const f32x4 a = o * ab[bj][n];
                            typedef unsigned u32x2_t __attribute__((ext_vector_type(2))); u32x2_t w; w.x = cvt_pk_bf16(a[0], a[1]); w.y = cvt_pk_bf16(a[2], a[3]); *(u32x2_t*)(hn + off + bj * HALF + n * 16) = w; } }
                if (NEXT) { sq += __shfl_xor(sq, 16); sq += __shfl_xor(sq, 32); if (fq == 0) atomicAdd(ssq + row, sq); }
            }
    }
};
struct EpiProj {
    static constexpr bool PERM = true, AFTER_DRAIN = false;
    bf16_t* O; const float* ropec; const float* ropes; float c2; const float* ss; const float* bias;
    __device__ __forceinline__ void operator()(const f32x4 (&acc)[2][2][4][2], const Unit& u, int wr, int wc, int fr, int fq) const {
        const int row0 = u.pm * BM + wr * 64 + fr;
        f32x4 bia[2][2];
        { const float* bp = bias + (size_t)(u.pm >> 4) * 3584 + u.pn * BM + wc * 32 + 8 * fq;
          bia[0][0] = *(const f32x4*)bp; bia[0][1] = *(const f32x4*)(bp + 4); bia[1][0] = *(const f32x4*)(bp + HALF); bia[1][1] = *(const f32x4*)(bp + HALF + 4); }
        if (u.pn < 4) {
            const float sc = (u.pn >= 2) ? 0.125f : 1.0f;
            const int i0 = 8 * fq, colb = u.pn * BM + wc * 64 + i0;
#pragma unroll
            for (int ai = 0; ai < 2; ++ai)
#pragma unroll
                for (int m = 0; m < 4; ++m) {
                    const int row = row0 + ai * HALF + m * 16, pos = row & 4095;
                    const f32x4 c0 = *(const f32x4*)(ropec + pos * 32 + i0), c1 = *(const f32x4*)(ropec + pos * 32 + i0 + 4);
                    const f32x4 s0 = *(const f32x4*)(ropes + pos * 32 + i0), s1 = *(const f32x4*)(ropes + pos * 32 + i0 + 4);
                    const float ri = __builtin_amdgcn_rsqf(ss[row] * (1.0f / 1024.0f) + 1e-6f);
                    const f32x4 xa = acc[ai][0][m][0] * ri + bia[0][0], xb = acc[ai][0][m][1] * ri + bia[0][1], ya = acc[ai][1][m][0] * ri + bia[1][0], yb = acc[ai][1][m][1] * ri + bia[1][1];
                    const f32x4 o1a = (xa * c0 - ya * s0) * sc, o1b = (xb * c1 - yb * s1) * sc, o2a = (xa * s0 + ya * c0) * sc, o2b = (xb * s1 + yb * c1) * sc;
                    bf16_t* rowp = O + (size_t)row * 3584 + colb;
                    u32x4 w; w.x = cvt_pk_bf16(o1a[0], o1a[1]); w.y = cvt_pk_bf16(o1a[2], o1a[3]); w.z = cvt_pk_bf16(o1b[0], o1b[1]); w.w = cvt_pk_bf16(o1b[2], o1b[3]);
                    *(u32x4*)rowp = w;
                    w.x = cvt_pk_bf16(o2a[0], o2a[1]); w.y = cvt_pk_bf16(o2a[2], o2a[3]); w.z = cvt_pk_bf16(o2b[0], o2b[1]); w.w = cvt_pk_bf16(o2b[2], o2b[3]);
                    *(u32x4*)(rowp + 32) = w;
                }
        } else {
            const int kind = (u.pn == 6 || u.pn == 7) ? 1 : ((u.pn == 8 || u.pn == 9) ? 2 : 0);
            const int col0 = u.pn * BM + wc * 32 + 8 * fq;
#pragma unroll
            for (int ai = 0; ai < 2; ++ai)
#pragma unroll
                for (int m = 0; m < 4; ++m) {
                    bf16_t* rowp = O + (size_t)(row0 + ai * HALF + m * 16) * 3584 + col0;
                    const float ri = __builtin_amdgcn_rsqf(ss[row0 + ai * HALF + m * 16] * (1.0f / 1024.0f) + 1e-6f);
#pragma unroll
                    for (int bj = 0; bj < 2; ++bj) {
                        f32x4 v0 = acc[ai][bj][m][0] * ri + bia[bj][0], v1 = acc[ai][bj][m][1] * ri + bia[bj][1];
                        if (kind == 1) {
#pragma unroll
                            for (int e = 0; e < 4; ++e) { v0[e] = fast_silu(v0[e]); v1[e] = fast_silu(v1[e]); }
                        } else if (kind == 2) { v0 = v0 * c2; v1 = v1 * c2; }
                        u32x4 w; w.x = cvt_pk_bf16(v0[0], v0[1]); w.y = cvt_pk_bf16(v0[2], v0[3]); w.z = cvt_pk_bf16(v1[0], v1[1]); w.w = cvt_pk_bf16(v1[2], v1[3]);
                        *(u32x4*)(rowp + bj * HALF) = w;
                    }
                }
        }
    }
};

template <class Epi, class Sched, bool ALIGN_EPI = false, bool SP2 = false>
__device__ __forceinline__ void gemm_phase(PG8_LAS unsigned char* lds, const Gemm g, const Sched& S, const Epi& E) {
    int tid_l = threadIdx.x; asm volatile("" : "+v"(tid_l));
    const int tid = tid_l, wid = __builtin_amdgcn_readfirstlane(tid >> 6), lane = tid & 63, wr = wid >> 2, wc = wid & 3, fr = lane & 15, fq = lane >> 4;
    const int K = g.K, nt = K / BK;
    unsigned voffA[2], voffB[2];
#pragma unroll
    for (int i = 0; i < 2; ++i) { int R, C; stage_rc(tid * 16 + i * 8192, R, C); const int Rb = Epi::PERM ? ((R & ~31) + perm32(R & 31)) : R;
        voffA[i] = (unsigned)(R * K + C) * 2u; voffB[i] = (unsigned)(Rb * K + C) * 2u; }
    const size_t kstep = (size_t)(BK * 2);
    const size_t hstep = (size_t)HALF * K * 2;
    const size_t tstep = 2 * hstep;
    const unsigned ldsw = (unsigned)wid * 1024u;
    const int aoff = lds_byte(wr * 64 + fr, fq * 8), boff = lds_byte(wc * 32 + fr, fq * 8);
#define PG8_SA(b, h) (((b) * 2 + (h)) * HTB)
#define PG8_SB(b, h) ((4 + (b) * 2 + (h)) * HTB)
#define PG8_STAGE(bufoff, gbase, voff) do { _Pragma("unroll") for (int _i = 0; _i < 2; ++_i) \
        __builtin_amdgcn_global_load_lds((const unsigned*)((const char*)(gbase) + (voff)[_i]), (PG8_LAS unsigned*)(lds + (bufoff) + ldsw + _i * 8192), 16, 0, 0); } while (0)
#define PG8_LDA(dst, b, h) do { _Pragma("unroll") for (int m = 0; m < 4; ++m) _Pragma("unroll") for (int k = 0; k < 2; ++k) dst[m][k] = *(const PG8_LAS bf16x8*)(lds + PG8_SA(b, h) + aoff + m * 2048 + k * 1024); } while (0)
#define PG8_LDB(dst, b, h) do { _Pragma("unroll") for (int n = 0; n < 2; ++n) _Pragma("unroll") for (int k = 0; k < 2; ++k) dst[n][k] = *(const PG8_LAS bf16x8*)(lds + PG8_SB(b, h) + boff + n * 2048 + k * 1024); } while (0)
#define PG8_MMA(ai, bj, At, Bt) do { __builtin_amdgcn_s_setprio(1); _Pragma("unroll") for (int m = 0; m < 4; ++m) _Pragma("unroll") for (int n = 0; n < 2; ++n) _Pragma("unroll") for (int k = 0; k < 2; ++k) \
        acc[ai][bj][m][n] = __builtin_amdgcn_mfma_f32_16x16x32_bf16(Bt[n][k], At[m][k], acc[ai][bj][m][n], 0, 0, 0); __builtin_amdgcn_s_setprio(0); } while (0)
#define PG8_WAIT_V(n) asm volatile("s_waitcnt vmcnt(" #n ")" ::: "memory")
#define PG8_WAIT_L(n) asm volatile("s_waitcnt lgkmcnt(" #n ")" ::: "memory")
#define PG8_BAR __builtin_amdgcn_s_barrier()
#define PG8_SCHED __builtin_amdgcn_sched_barrier(0)
    Unit cur, nxt; int ui = 0;
    if (!S.next(0, cur)) return;
    f32x4 acc[2][2][4][2];
#pragma unroll
    for (int a = 0; a < 2; ++a)
#pragma unroll
        for (int b = 0; b < 2; ++b)
#pragma unroll
            for (int m = 0; m < 4; ++m)
#pragma unroll
                for (int n = 0; n < 2; ++n) acc[a][b][m][n] = (f32x4){0.f, 0.f, 0.f, 0.f};
    bf16x8 At[4][2], B0[2][2], B1[2][2];
    const char* cA = (const char*)g.A + (size_t)cur.pm * tstep; const char* cB = (const char*)g.Bt + (size_t)cur.pn * tstep;
    S.a_ready(cur);
    if constexpr (SP2) {
        PG8_STAGE(PG8_SB(0, 0), cB, voffB); PG8_STAGE(PG8_SB(0, 1), cB + hstep, voffB); PG8_STAGE(PG8_SA(0, 0), cA, voffA); PG8_STAGE(PG8_SA(0, 1), cA + hstep, voffA);
        if (wr == 1) PG8_BAR;
        PG8_WAIT_V(2); PG8_BAR;
        PG8_STAGE(PG8_SB(1, 0), cB + kstep, voffB); PG8_STAGE(PG8_SA(1, 0), cA + kstep, voffA); PG8_STAGE(PG8_SB(1, 1), cB + hstep + kstep, voffB);
        PG8_WAIT_V(6); PG8_BAR;
    } else {
        PG8_STAGE(PG8_SB(0, 0), cB, voffB); PG8_STAGE(PG8_SA(0, 0), cA, voffA); PG8_STAGE(PG8_SB(0, 1), cB + hstep, voffB); PG8_STAGE(PG8_SA(0, 1), cA + hstep, voffA);
        if (wr == 1) PG8_BAR;
        PG8_WAIT_V(4); PG8_BAR;
        PG8_STAGE(PG8_SB(1, 0), cB + kstep, voffB); PG8_STAGE(PG8_SA(1, 0), cA + kstep, voffA); PG8_STAGE(PG8_SB(1, 1), cB + hstep + kstep, voffB);
        PG8_WAIT_V(6); PG8_BAR;
    }
    for (;;) {
        const bool has_next = S.next(ui + 1, nxt);
        const char* nA = has_next ? (const char*)g.A + (size_t)nxt.pm * tstep : cA; const char* nB = has_next ? (const char*)g.Bt + (size_t)nxt.pn * tstep : cB;
        for (int t = 0; t < nt; t += 2) {
            const bool last = (t == nt - 2);
            const char* a1 = cA + (size_t)(t + 1) * kstep;
            const char* a2 = last ? nA : cA + (size_t)(t + 2) * kstep; const char* b2 = last ? nB : cB + (size_t)(t + 2) * kstep;
            const char* a3 = a2 + kstep; const char* b3 = b2 + kstep;
            if (last && has_next) S.a_ready(nxt);
            if constexpr (SP2) {
            PG8_LDB(B0, 0, 0); PG8_LDB(B1, 0, 1); PG8_SCHED; PG8_LDA(At, 0, 0); PG8_STAGE(PG8_SA(1, 1), a1 + hstep, voffA);
            PG8_WAIT_V(8); PG8_WAIT_L(0); PG8_BAR; PG8_MMA(0, 0, At, B0); PG8_MMA(0, 1, At, B1); PG8_BAR; PG8_SCHED;
            PG8_LDA(At, 0, 1); PG8_STAGE(PG8_SB(0, 0), b2, voffB); PG8_STAGE(PG8_SB(0, 1), b2 + hstep, voffB); PG8_STAGE(PG8_SA(0, 0), a2, voffA);
            PG8_WAIT_V(8); PG8_WAIT_L(0); PG8_BAR; PG8_MMA(1, 0, At, B0); PG8_MMA(1, 1, At, B1); PG8_BAR; PG8_SCHED;
            PG8_LDB(B0, 1, 0); PG8_LDB(B1, 1, 1); PG8_SCHED; PG8_LDA(At, 1, 0); PG8_STAGE(PG8_SA(0, 1), a2 + hstep, voffA);
            PG8_WAIT_V(8); PG8_WAIT_L(0); PG8_BAR; PG8_MMA(0, 0, At, B0); PG8_MMA(0, 1, At, B1); PG8_BAR; PG8_SCHED;
            PG8_LDA(At, 1, 1); PG8_STAGE(PG8_SB(1, 0), b3, voffB); PG8_STAGE(PG8_SB(1, 1), b3 + hstep, voffB); PG8_STAGE(PG8_SA(1, 0), a3, voffA);
            PG8_WAIT_V(8); PG8_WAIT_L(0); PG8_BAR; PG8_MMA(1, 0, At, B0); PG8_MMA(1, 1, At, B1); PG8_BAR; PG8_SCHED;
            } else {
            PG8_LDB(B0, 0, 0); PG8_SCHED; PG8_LDA(At, 0, 0); PG8_STAGE(PG8_SA(1, 1), a1 + hstep, voffA);
            PG8_WAIT_L(8); PG8_BAR; PG8_WAIT_L(0); PG8_MMA(0, 0, At, B0); PG8_BAR; PG8_SCHED;
            PG8_LDB(B1, 0, 1); PG8_STAGE(PG8_SB(0, 0), b2, voffB);
            PG8_BAR; PG8_WAIT_L(0); PG8_MMA(0, 1, At, B1); PG8_BAR;
            PG8_LDA(At, 0, 1); PG8_STAGE(PG8_SA(0, 0), a2, voffA);
            PG8_BAR; PG8_WAIT_L(0); PG8_MMA(1, 0, At, B0); PG8_BAR; PG8_SCHED;
            PG8_STAGE(PG8_SB(0, 1), b2 + hstep, voffB);
            PG8_WAIT_V(6); PG8_BAR; PG8_MMA(1, 1, At, B1); PG8_BAR;
            PG8_LDB(B0, 1, 0); PG8_SCHED; PG8_LDA(At, 1, 0); PG8_STAGE(PG8_SA(0, 1), a2 + hstep, voffA);
            PG8_WAIT_L(8); PG8_BAR; PG8_WAIT_L(0); PG8_MMA(0, 0, At, B0); PG8_BAR; PG8_SCHED;
            PG8_LDB(B1, 1, 1); PG8_STAGE(PG8_SB(1, 0), b3, voffB);
            PG8_BAR; PG8_WAIT_L(0); PG8_MMA(0, 1, At, B1); PG8_BAR;
            PG8_LDA(At, 1, 1); PG8_STAGE(PG8_SA(1, 0), a3, voffA);
            PG8_BAR; PG8_WAIT_L(0); PG8_MMA(1, 0, At, B0); PG8_BAR; PG8_SCHED;
            PG8_STAGE(PG8_SB(1, 1), b3 + hstep, voffB);
            PG8_WAIT_V(6); PG8_BAR; PG8_MMA(1, 1, At, B1); PG8_BAR;
            }
        }
        if constexpr (ALIGN_EPI) { if (wr == 0) PG8_BAR; }
        if constexpr (!Epi::AFTER_DRAIN) { E(acc, cur, wr, wc, fr, fq); S.done(cur); }
        if (!has_next) break;
#pragma unroll
        for (int a = 0; a < 2; ++a)
#pragma unroll
            for (int b = 0; b < 2; ++b)
#pragma unroll
                for (int m = 0; m < 4; ++m)
#pragma unroll
                    for (int n = 0; n < 2; ++n) acc[a][b][m][n] = (f32x4){0.f, 0.f, 0.f, 0.f};
        cur = nxt; cA = nA; cB = nB; ++ui;
        if constexpr (ALIGN_EPI) { if (wr == 1) PG8_BAR; }
    }
    PG8_WAIT_V(0);
    if constexpr (!ALIGN_EPI) { if (wr == 0) PG8_BAR; }
    PG8_BAR;
    if constexpr (Epi::AFTER_DRAIN) { E.fused(acc, cur, wr, wc, fr, fq, lds, wid, lane); S.done(cur); }
#undef PG8_SA
#undef PG8_SB
#undef PG8_STAGE
#undef PG8_LDA
#undef PG8_LDB
#undef PG8_MMA
#undef PG8_WAIT_V
#undef PG8_WAIT_L
#undef PG8_BAR
#undef PG8_SCHED
}
}
#include <hip/hip_bf16.h>
#include <cmath>
namespace attn_body {
using bf16=__hip_bfloat16;
using bf16x8=__attribute__((ext_vector_type(8)))short;
using s16x4=__attribute__((ext_vector_type(4)))short;
using f32x16=__attribute__((ext_vector_type(16)))float;
using u32x4=__attribute__((ext_vector_type(4)))unsigned;
constexpr int SEQ=4096,D=64,PQ=3584,PO=1024;
constexpr int NW=8,QBLK=32,QB=QBLK*NW,KVBLK=64,NQB=SEQ/QB;
constexpr int ATTN_UNIT_ROWS=QB;
__device__ __forceinline__ int crow(int r,int hi){return (r&3)+8*(r>>2)+4*hi;}
#define SBAR() __builtin_amdgcn_sched_barrier(0)
typedef __attribute__((address_space(3))) const float* lds_cfptr;
__device__ __forceinline__ void cmask(f32x16&p0,f32x16&p1,int jb,int qrel,int hi,lds_cfptr rt){
  const float NEG=-INFINITY; const int base=qrel-64*jb-4*hi;
  lds_cfptr a=rt+(383-base);
  #pragma unroll
  for(int g=0;g<4;++g){
    #pragma unroll
    for(int rr=0;rr<4;++rr){const int r=4*g+rr,o=(r&3)+8*(r>>2);
      const float d0=a[o],d1=a[o+32];
      p0[r]=(base-o<0)?NEG:p0[r]+d0; p1[r]=(base-o-32<0)?NEG:p1[r]+d1;}
    __builtin_amdgcn_sched_barrier(0);
  }
}

constexpr int NSLOT=3, SLOTB=8192;
constexpr int LDS_K=0, LDS_V=NSLOT*SLOTB, LDS_WS=2*NSLOT*SLOTB, LDS_OST=LDS_WS+NW*64*4, LDS_TAB=LDS_OST+NW*4096, LDS_BYTES=LDS_TAB+2560;
constexpr float C2=0.125f*1.4426950408889634f;
__device__ __forceinline__ void glds16(const void*gsrc,unsigned lds_dst){unsigned keep;
  asm volatile("s_mov_b32 %0, m0\n\ts_mov_b32 m0, %2\n\ts_nop 0\n\tglobal_load_lds_dwordx4 %1, off\n\ts_mov_b32 m0, %0":"=&s"(keep):"v"(gsrc),"s"(lds_dst):"memory");}
__device__ __forceinline__ float max3f(float a,float b,float c){float r;asm("v_max3_f32 %0, %1, %2, %3":"=v"(r):"v"(a),"v"(b),"v"(c));return r;}
__device__ __forceinline__ float max2f(float a,float b){float r;asm("v_max_f32_e32 %0, %1, %2":"=v"(r):"v"(a),"v"(b));return r;}
__device__ __forceinline__ float fadd_s(float a,float b){float r;asm("v_add_f32_e32 %0, %1, %2":"=v"(r):"v"(a),"v"(b));return r;}
__device__ __forceinline__ float fsub_s(float a,float b){float r;asm("v_sub_f32_e32 %0, %1, %2":"=v"(r):"v"(a),"v"(b));return r;}
typedef float f32x2_t __attribute__((ext_vector_type(2))); typedef __bf16 bf16x2_t __attribute__((ext_vector_type(2)));
__device__ __forceinline__ unsigned cvtpk_s(float lo,float hi){f32x2_t v={lo,hi};bf16x2_t b=__builtin_convertvector(v,bf16x2_t);return __builtin_bit_cast(unsigned,b);}
#define WAIT_BAR(N) asm volatile("s_waitcnt vmcnt(" #N ") lgkmcnt(0)\n\ts_barrier":::"memory")

__device__ __forceinline__ void qkt(f32x16&p0,f32x16&p1,const char*Kslot,const bf16x8*qr,const f32x16&negm,int r32,int hi){
  const char*kb=Kslot+hi*1024+r32*16;
  #pragma unroll
  for(int d0=0;d0<4;++d0){
    const bf16x8 b0=*reinterpret_cast<const bf16x8*>(kb+d0*2048);
    const bf16x8 b1=*reinterpret_cast<const bf16x8*>(kb+d0*2048+512);
    if(d0==0){p0=__builtin_amdgcn_mfma_f32_32x32x16_bf16(b0,qr[0],negm,0,0,0);p1=__builtin_amdgcn_mfma_f32_32x32x16_bf16(b1,qr[0],negm,0,0,0);}
    else{p0=__builtin_amdgcn_mfma_f32_32x32x16_bf16(b0,qr[d0],p0,0,0,0);p1=__builtin_amdgcn_mfma_f32_32x32x16_bf16(b1,qr[d0],p1,0,0,0);}}
}
typedef __attribute__((address_space(3))) const char* lds_cptr;
typedef short v4i16_t __attribute__((ext_vector_type(4)));
__device__ __forceinline__ void kload8(bf16x8*kf,lds_cptr kp){
  kf[0]=*(const __attribute__((address_space(3))) bf16x8*)(kp);      kf[1]=*(const __attribute__((address_space(3))) bf16x8*)(kp+512);
  kf[2]=*(const __attribute__((address_space(3))) bf16x8*)(kp+2048); kf[3]=*(const __attribute__((address_space(3))) bf16x8*)(kp+2560);
  kf[4]=*(const __attribute__((address_space(3))) bf16x8*)(kp+4096); kf[5]=*(const __attribute__((address_space(3))) bf16x8*)(kp+4608);
  kf[6]=*(const __attribute__((address_space(3))) bf16x8*)(kp+6144); kf[7]=*(const __attribute__((address_space(3))) bf16x8*)(kp+6656);
}
__device__ __forceinline__ void kload2(bf16x8*kf,lds_cptr kp,int j){ kf[2*j]=*(const __attribute__((address_space(3))) bf16x8*)(kp+j*2048); kf[2*j+1]=*(const __attribute__((address_space(3))) bf16x8*)(kp+j*2048+512); }
__device__ __forceinline__ s16x4 vtr(lds_cptr p){ return __builtin_bit_cast(s16x4,__builtin_amdgcn_ds_read_tr16_b64_v4i16((__attribute__((address_space(3))) v4i16_t*)p)); }
__device__ __forceinline__ float rowmax(const f32x16&p0,const f32x16&p1){
  float a=max3f(p0[0],p0[1],p1[0]),b=max3f(p0[2],p0[3],p1[1]);a=max3f(a,p1[2],p1[3]);
  #pragma unroll
  for(int r=4;r<16;r+=4){a=max3f(a,p0[r],p0[r+1]);b=max3f(b,p0[r+2],p0[r+3]);a=max3f(a,p1[r],p1[r+1]);b=max3f(b,p1[r+2],p1[r+3]);}
  const float m=max2f(a,b);
  auto rr=__builtin_amdgcn_permlane32_swap(__float_as_uint(m),__float_as_uint(m),false,false);
  return max2f(__uint_as_float(rr[0]),__uint_as_float(rr[1]));
}
__device__ __forceinline__ void pv(f32x16*o,int vb,bf16x8 pa0,bf16x8 pa1,bf16x8 pa2,bf16x8 pa3){
  #pragma unroll
  for(int d0=0;d0<2;++d0){s16x4 lo[4],hi[4];
    #pragma unroll
    for(int ks=0;ks<4;++ks){
      asm volatile("ds_read_b64_tr_b16 %0,%1 offset:%c2":"=&v"(lo[ks]):"v"(vb),"i"(d0*4096+ks*1024):"memory");
      asm volatile("ds_read_b64_tr_b16 %0,%1 offset:%c2":"=&v"(hi[ks]):"v"(vb),"i"(d0*4096+ks*1024+512):"memory");}
    asm volatile("s_waitcnt lgkmcnt(0)":::"memory");SBAR();
    #define PK(k) (bf16x8){lo[k][0],lo[k][1],lo[k][2],lo[k][3],hi[k][0],hi[k][1],hi[k][2],hi[k][3]}
    o[d0]=__builtin_amdgcn_mfma_f32_32x32x16_bf16(pa0,PK(0),o[d0],0,0,0);
    o[d0]=__builtin_amdgcn_mfma_f32_32x32x16_bf16(pa1,PK(1),o[d0],0,0,0);
    o[d0]=__builtin_amdgcn_mfma_f32_32x32x16_bf16(pa2,PK(2),o[d0],0,0,0);
    o[d0]=__builtin_amdgcn_mfma_f32_32x32x16_bf16(pa3,PK(3),o[d0],0,0,0);
    #undef PK
  }
}

#ifndef ATTN_STORE16
#define ATTN_STORE16(p,v) (*(u32x4*)(p)=(v))
#endif
template<int THRL> __device__ __forceinline__ void attn_unit(int qb,const bf16*Qb,const bf16*__restrict__ Kh,const bf16*__restrict__ Vh,bf16*Ob,const float*tabg,float cfar,char*shm){
  int tid_l=threadIdx.x; asm volatile("":"+v"(tid_l));
  const int tid=tid_l,lane=tid&63,r32=lane&31,hi=lane>>5; const int wid=__builtin_amdgcn_readfirstlane(tid>>6);
  const int q0=qb*QB;
  const bf16*Qw=Qb+(long)(q0+wid*QBLK)*PQ;
  const unsigned lds0=(unsigned)(uintptr_t)shm;
  float*wsf=(float*)(shm+LDS_WS)+wid*64;
  const bf16*ksrc=Kh+(long)lane*PQ+wid*8;
  const bf16*vsrc=Vh+(long)(16*(wid&3)+(lane>>2))*PQ+(wid>>2)*32+(lane&3)*8;
  const unsigned kdst=lds0+LDS_K+wid*1024, vdst=lds0+LDS_V+wid*1024;
  #define DMA_K(t,slot) glds16(ksrc+(long)(t)*KVBLK*PQ,(unsigned)__builtin_amdgcn_readfirstlane(kdst+(slot)))
  #define DMA_V(t,slot) glds16(vsrc+(long)(t)*KVBLK*PQ,(unsigned)__builtin_amdgcn_readfirstlane(vdst+(slot)))
  const int vb0=(int)(lds0+LDS_V)+((lane>>4)&1)*32+(lane&3)*8+(4*hi+((lane&15)>>2))*64;
  const char*Kbase=shm+LDS_K; bf16x8 kf[8];
  const lds_cptr shm3=(lds_cptr)shm; const lds_cptr kp0=shm3+LDS_K+hi*1024+r32*16; const lds_cptr vp0=shm3+LDS_V+((lane>>4)&1)*32+(lane&3)*8+(4*hi+((lane&15)>>2))*64;
  const int NT=(q0+QB)/KVBLK;
  const lds_cfptr tab=(lds_cfptr)((lds_cptr)shm+LDS_TAB);
  for(int j=tid;j<640;j+=512){const int n=383-j; ((__attribute__((address_space(3))) float*)((__attribute__((address_space(3))) char*)shm+LDS_TAB))[j]=(n>=0&&n<113)?tabg[n]:0.f;}
  DMA_K(0,0);DMA_V(0,0);DMA_K(1,SLOTB);
  bf16x8 qr[4];
  #pragma unroll
  for(int d0=0;d0<4;++d0)qr[d0]=*reinterpret_cast<const bf16x8*>(&Qw[(long)r32*PQ+d0*16+hi*8]);
  float mhat=0.f,l_reg=0.f;f32x16 o[2];o[0]=f32x16{};o[1]=f32x16{};f32x16 negm;
  #pragma unroll
  for(int r=0;r<16;++r)negm[r]=cfar;
  asm volatile("":"+v"(negm));
  const int qrel=wid*QBLK+r32;
  #define CMASK(P0,P1,t) do{int jb_=(t)-(NT-4); if(jb_>=-2)cmask(P0,P1,jb_,qrel,hi,tab);}while(0)
  bool resc=false;
  #define START(P0,P1) do{ const float rm=rowmax(P0,P1); resc=false; \
    { const float dl=rm; mhat=fadd_s(mhat,dl); \
      _Pragma("unroll") for(int r=0;r<16;++r){P0[r]=fsub_s(P0[r],dl);P1[r]=fsub_s(P1[r],dl);} \
      _Pragma("unroll") for(int r=0;r<16;++r)negm[r]=cfar-mhat; asm volatile("":"+v"(negm)); } \
    _Pragma("unroll") for(int r=0;r<16;++r)P0[r]=__builtin_amdgcn_exp2f(P0[r]); }while(0)
  #define RESC() do{ if(resc){ asm volatile("s_waitcnt lgkmcnt(0)":::"memory"); \
      _Pragma("unroll") for(int d_=0;d_<2;++d_) _Pragma("unroll") for(int r=0;r<16;++r)o[d_][r]*=wsf[crow(r,hi)]; } }while(0)
  f32x16 pA0,pA1,pB0,pB1;
  int sl_prev=0,sl_cur=0,sl_next=SLOTB;
  #define ROT() do{sl_prev=sl_cur;sl_cur=sl_next;sl_next=(sl_next==(NSLOT-1)*SLOTB)?0:sl_next+SLOTB;}while(0)
  DMA_K(2,2*SLOTB);
  WAIT_BAR(3);
  qkt(pA0,pA1,Kbase,qr,negm,r32,hi);asm volatile("s_nop 15\n\ts_nop 7":"+v"(pA0),"+v"(pA1));CMASK(pA0,pA1,0);
  START(pA0,pA1);
  _Pragma("unroll") for(int r=0;r<16;++r)pA1[r]=__builtin_amdgcn_exp2f(pA1[r]);
  WAIT_BAR(0);
  DMA_K(3,0);DMA_V(1,SLOTB);
  ROT();
  kload8(kf,kp0+sl_cur);
  WAIT_BAR(2);
  s16x4 vlo[8],vhi[8]; u32x4 pw0,pw1,pw2,pw3;
  #define PKW(P,B) cvtpk_s(P[B],P[B+1])
  #define PAF(k) __builtin_bit_cast(bf16x8,pw##k)
  #define VFR(i) (bf16x8){vlo[i][0],vlo[i][1],vlo[i][2],vlo[i][3],vhi[i][0],vhi[i][1],vhi[i][2],vhi[i][3]}
  #define PIN(x) asm volatile("":"+v"(x))
  #define MX3(a,b,c) __builtin_fmaxf(__builtin_fmaxf((a),(b)),(c))
  #define GAPA(MF,A0,A1,A2,A3,W0,W1,PW) do{ MF; sacc+=A0; sacc+=A1; sacc+=A2; sacc+=A3; PIN(sacc); W0; W1; PIN(PW); SBAR(); }while(0)
  #define EX(v) __builtin_amdgcn_exp2f(v)
  #define GAPB(MF,X,B) do{ MF; X[B]=EX(X[B]); X[B+1]=EX(X[B+1]); X[B+2]=EX(X[B+2]); X[B+3]=EX(X[B+3]); PIN(X); SBAR(); }while(0)
  #define VRD(i) do{ vlo[i]=vtr(vp_+(((i)>>2)*4096+((i)&3)*1024)); vhi[i]=vtr(vp_+(((i)>>2)*4096+((i)&3)*1024+512)); }while(0)
  #define KRD(G,j) do{ if(G){ kload2(kf,kp0+sl_next,j); SBAR(); } }while(0)
  #define STEP(C0,C1,P0,P1,t,GK,GV,GL) do{ SBAR(); \
    const lds_cptr vp_=vp0+sl_prev; \
    VRD(0); SBAR(); float sacc=(P0[0]+P0[1]); \
    GAPA(C0=__builtin_amdgcn_mfma_f32_32x32x16_bf16(kf[0],qr[0],negm,0,0,0), P0[2],P0[3],P0[4],P0[5],     pw0[0]=PKW(P0,0), pw0[1]=PKW(P0,2), pw0); \
    VRD(4); SBAR(); GAPA(C1=__builtin_amdgcn_mfma_f32_32x32x16_bf16(kf[1],qr[0],negm,0,0,0), P0[6],P0[7],P0[8],P0[9],     pw0[2]=PKW(P0,4), pw0[3]=PKW(P0,6), pw0); \
    VRD(1); SBAR(); GAPA(C0=__builtin_amdgcn_mfma_f32_32x32x16_bf16(kf[2],qr[1],C0,0,0,0),   P0[10],P0[11],P0[12],P0[13], pw1[0]=PKW(P0,8), pw1[1]=PKW(P0,10), pw1); \
    VRD(5); SBAR(); GAPA(C1=__builtin_amdgcn_mfma_f32_32x32x16_bf16(kf[3],qr[1],C1,0,0,0),   P0[14],P0[15],P1[0],P1[1],   pw1[2]=PKW(P0,12),pw1[3]=PKW(P0,14), pw1); \
    VRD(2); SBAR(); GAPA(C0=__builtin_amdgcn_mfma_f32_32x32x16_bf16(kf[4],qr[2],C0,0,0,0),   P1[2],P1[3],P1[4],P1[5],     pw2[0]=PKW(P1,0), pw2[1]=PKW(P1,2), pw2); \
    VRD(6); SBAR(); GAPA(C1=__builtin_amdgcn_mfma_f32_32x32x16_bf16(kf[5],qr[2],C1,0,0,0),   P1[6],P1[7],P1[8],P1[9],     pw2[2]=PKW(P1,4), pw2[3]=PKW(P1,6), pw2); \
    VRD(3); SBAR(); GAPA(C0=__builtin_amdgcn_mfma_f32_32x32x16_bf16(kf[6],qr[3],C0,0,0,0),   P1[10],P1[11],P1[12],P1[13], pw3[0]=PKW(P1,8), pw3[1]=PKW(P1,10), pw3); \
    VRD(7); SBAR(); GAPA(C1=__builtin_amdgcn_mfma_f32_32x32x16_bf16(kf[7],qr[3],C1,0,0,0),   P1[14],P1[15],0.f,0.f,       pw3[2]=PKW(P1,12),pw3[3]=PKW(P1,14), pw3); \
    l_reg+=sacc; \
    if(GK){DMA_K((t)+3,sl_cur);} if(GV){DMA_V((t)+1,sl_next);} \
    CMASK(C0,C1,t); \
    { float a=MX3(C0[0],C0[1],C1[0]),b=MX3(C0[2],C0[3],C1[1]); a=MX3(a,C1[2],C1[3]); \
      _Pragma("unroll") for(int r=4;r<16;r+=4){a=MX3(a,C0[r],C0[r+1]);b=MX3(b,C0[r+2],C0[r+3]);a=MX3(a,C1[r],C1[r+1]);b=MX3(b,C1[r+2],C1[r+3]);} \
      float rm=__builtin_fmaxf(a,b); { auto rr=__builtin_amdgcn_permlane32_swap(__float_as_uint(rm),__float_as_uint(rm),false,false); rm=__builtin_fmaxf(__uint_as_float(rr[0]),__uint_as_float(rr[1])); } \
      resc=false; \
      if(__builtin_expect(__any(rm>(float)THRL),0)){ const float dl=__builtin_fmaxf(rm,0.f); mhat+=dl; \
        _Pragma("unroll") for(int r=0;r<16;++r){C0[r]-=dl;C1[r]-=dl;} \
        _Pragma("unroll") for(int r=0;r<16;++r)negm[r]=cfar-mhat; asm volatile("":"+v"(negm)); \
        const float f=__builtin_amdgcn_exp2f(-dl); l_reg*=f; if(hi==0)wsf[r32]=f; resc=true; } } \
    SBAR(); \
    GAPB(o[0]=__builtin_amdgcn_mfma_f32_32x32x16_bf16(PAF(0),VFR(0),o[0],0,0,0), C0,0); \
    GAPB(o[1]=__builtin_amdgcn_mfma_f32_32x32x16_bf16(PAF(0),VFR(4),o[1],0,0,0), C0,4); \
    KRD(GL,0); GAPB(o[0]=__builtin_amdgcn_mfma_f32_32x32x16_bf16(PAF(1),VFR(1),o[0],0,0,0), C0,8); \
    KRD(GL,1); GAPB(o[1]=__builtin_amdgcn_mfma_f32_32x32x16_bf16(PAF(1),VFR(5),o[1],0,0,0), C0,12); \
    KRD(GL,2); GAPB(o[0]=__builtin_amdgcn_mfma_f32_32x32x16_bf16(PAF(2),VFR(2),o[0],0,0,0), C1,0); \
    KRD(GL,3); GAPB(o[1]=__builtin_amdgcn_mfma_f32_32x32x16_bf16(PAF(2),VFR(6),o[1],0,0,0), C1,4); \
    GAPB(o[0]=__builtin_amdgcn_mfma_f32_32x32x16_bf16(PAF(3),VFR(3),o[0],0,0,0), C1,8); \
    GAPB(o[1]=__builtin_amdgcn_mfma_f32_32x32x16_bf16(PAF(3),VFR(7),o[1],0,0,0), C1,12); \
    }while(0)
  int t=1;
  #undef CMASK
  #define CMASK(P0,P1,t) do{}while(0)
  for(;t+7<NT;t+=2){
    STEP(pB0,pB1,pA0,pA1,t,true,true,true);     WAIT_BAR(2); RESC(); ROT();
    STEP(pA0,pA1,pB0,pB1,t+1,true,true,true);   WAIT_BAR(2); RESC(); ROT();
  }
  #undef CMASK
  #define CMASK(P0,P1,t) do{int jb_=(t)-(NT-4); if(jb_>=-2)cmask(P0,P1,jb_,qrel,hi,tab);}while(0)
  #define ENDW(tt) do{ if((tt)+3<NT){WAIT_BAR(2);} else if((tt)+2<NT){WAIT_BAR(1);} else {WAIT_BAR(0);} }while(0)
  for(;t+1<NT;t+=2){
    STEP(pB0,pB1,pA0,pA1,t,(t+3<NT),(t+1<NT),(t+1<NT));       ENDW(t);   RESC(); ROT();
    STEP(pA0,pA1,pB0,pB1,t+1,(t+4<NT),(t+2<NT),(t+2<NT));     ENDW(t+1); RESC(); ROT();
  }
  STEP(pB0,pB1,pA0,pA1,NT-1,false,false,false); RESC();
  { float sacc=pB0[0]+pB0[1]; _Pragma("unroll") for(int r=2;r<16;++r)sacc+=pB0[r]; _Pragma("unroll") for(int r=0;r<16;++r)sacc+=pB1[r]; l_reg+=sacc;
    pw0=(u32x4){PKW(pB0,0),PKW(pB0,2),PKW(pB0,4),PKW(pB0,6)};pw1=(u32x4){PKW(pB0,8),PKW(pB0,10),PKW(pB0,12),PKW(pB0,14)};pw2=(u32x4){PKW(pB1,0),PKW(pB1,2),PKW(pB1,4),PKW(pB1,6)};pw3=(u32x4){PKW(pB1,8),PKW(pB1,10),PKW(pB1,12),PKW(pB1,14)};
    SBAR(); pv(o,vb0+sl_cur,PAF(0),PAF(1),PAF(2),PAF(3)); }
  #undef PKW
  #undef PAF
  #undef VFR
  #undef PIN
  #undef MX3
  #undef GAPA
  #undef GAPB
  #undef EX
  #undef VRD
  #undef KRD
  #undef STEP
  #undef ENDW
  {auto rr=__builtin_amdgcn_permlane32_swap(__float_as_uint(l_reg),__float_as_uint(l_reg),false,false);l_reg=__uint_as_float(rr[0])+__uint_as_float(rr[1]);}
  if(hi==0)wsf[32+r32]=l_reg;asm volatile("s_waitcnt lgkmcnt(0)":::"memory");
  float rli[16];
  #pragma unroll
  for(int r=0;r<16;++r)rli[r]=__builtin_amdgcn_rcpf(wsf[32+crow(r,hi)]);
  bf16*Ow=Ob+(long)(q0+wid*QBLK)*PO;
  { bf16*stg=(bf16*)(shm+LDS_OST)+wid*2048;
    #pragma unroll
    for(int r=0;r<16;++r){const int orow=crow(r,hi);
      #pragma unroll
      for(int d0=0;d0<2;++d0)stg[orow*64+d0*32+r32]=__float2bfloat16(o[d0][r]*rli[r]);}
    asm volatile("s_waitcnt lgkmcnt(0)":::"memory");
    #pragma unroll
    for(int i=0;i<4;++i){const int row=i*8+(lane>>3),ch=lane&7; const u32x4 v=*(const u32x4*)(stg+row*64+ch*8); ATTN_STORE16(Ow+(long)row*PO+ch*8,v);} }
  asm volatile("s_waitcnt lgkmcnt(0)\n\ts_barrier":::"memory");
  #undef DMA_K
  #undef DMA_V
  #undef CMASK
  #undef START
  #undef RESC
  #undef ROT
}
constexpr int ATTN_LDS_BYTES=LDS_BYTES;
template<int THRL=8> __device__ __forceinline__ void attn_phase(char*lds,const bf16*P,bf16*O,const float*TAB,const float*CFAR,int grid,int block){
  const int vcu=(grid%8==0)?(block%8)*(grid/8)+block/8:block;
  for(int vh=vcu>>1;vh<128;vh+=(grid>>1)){
    const int half=vh&1,m=(vh>>1)&1,h=(vh>>2)&3,b=vh>>4;
    const bf16*Pb=P+(long)b*SEQ*PQ;
    const float cf=CFAR[h];
    for(int i=0;i<8;++i){ const int s=4*(vcu&1)+(i>>1); const int qb=(i&1)?15-s:s;
      attn_unit<THRL>(qb,Pb+2048+h*128+m*64,Pb+2560+h*128+m*64,Pb+3072+h*128+half*64,O+(long)b*SEQ*PO+((h*2+m)*2+half)*64,TAB+h*128,cf,lds); }
  }
}
#undef SBAR
#undef WAIT_BAR
}
namespace ret {
typedef short bf16x8 __attribute__((ext_vector_type(8)));
typedef short s16x4 __attribute__((ext_vector_type(4)));
typedef float f32x4 __attribute__((ext_vector_type(4)));
typedef unsigned u32x4 __attribute__((ext_vector_type(4)));
typedef unsigned u32x2 __attribute__((ext_vector_type(2)));
#define RLAS __attribute__((address_space(3)))
typedef RLAS unsigned char* ldsptr;
constexpr int RS = 72, PS = 136;
constexpr int OFF_Q = 0, OFF_K = 18432, OFF_KZ = 36864, OFF_V = 55296, OFF_RT = 73728, OFF_P = 82944, RET_LDS = 117760;
constexpr int NINP = 3584, SEQL = 4096;
__device__ __forceinline__ unsigned f2bf_(float f) { unsigned u = __builtin_bit_cast(unsigned, f); return (u + 0x7fffu + ((u >> 16) & 1u)) >> 16; }
__device__ __forceinline__ unsigned pk2_(float lo, float hi) { return f2bf_(lo) | (f2bf_(hi) << 16); }
__device__ __forceinline__ float bf2f_(unsigned h) { return __builtin_bit_cast(float, h << 16); }
__device__ __forceinline__ bf16x8 ldA(ldsptr base, int row, int col, int stride) { return *(const RLAS bf16x8*)(base + (row * stride + col) * 2); }
__device__ __forceinline__ bf16x8 ldT(ldsptr base, int k0, int n0, int c, int q) {
    typedef short v4i16_t __attribute__((ext_vector_type(4)));
    ldsptr p = base + ((k0 + 8 * q + (c >> 2)) * RS + n0 + 4 * (c & 3)) * 2;
    const s16x4 lo = __builtin_bit_cast(s16x4, __builtin_amdgcn_ds_read_tr16_b64_v4i16((RLAS v4i16_t*)p));
    const s16x4 hi = __builtin_bit_cast(s16x4, __builtin_amdgcn_ds_read_tr16_b64_v4i16((RLAS v4i16_t*)(p + 4 * RS * 2)));
    return (bf16x8){lo[0], lo[1], lo[2], lo[3], hi[0], hi[1], hi[2], hi[3]};
}
#define MFMA16(a, b, c) __builtin_amdgcn_mfma_f32_16x16x32_bf16((a), (b), (c), 0, 0, 0)
__device__ __forceinline__ float row16_sum(float v) {
    v += __builtin_bit_cast(float, __builtin_amdgcn_update_dpp(0, __builtin_bit_cast(int, v), 0x128, 0xf, 0xf, false));
    v += __builtin_bit_cast(float, __builtin_amdgcn_update_dpp(0, __builtin_bit_cast(int, v), 0x124, 0xf, 0xf, false));
    v += __builtin_bit_cast(float, __builtin_amdgcn_update_dpp(0, __builtin_bit_cast(int, v), 0x122, 0xf, 0xf, false));
    v += __builtin_bit_cast(float, __builtin_amdgcn_update_dpp(0, __builtin_bit_cast(int, v), 0x121, 0xf, 0xf, false));
    return v;
}

__device__ __forceinline__ void state_update(ldsptr lds, f32x4 (&acc_s)[2], float gc, int w, int c, int q) {
    const int dt = w >> 1, et0 = 2 * (w & 1);
    acc_s[0] = acc_s[0] * gc; acc_s[1] = acc_s[1] * gc;
#pragma unroll
    for (int ks = 0; ks < 4; ++ks) {
        const bf16x8 a = ldT(lds + OFF_KZ, 32 * ks, 16 * dt, c, q);
#pragma unroll
        for (int t2 = 0; t2 < 2; ++t2) acc_s[t2] = MFMA16(a, ldT(lds + OFF_V, 32 * ks, 16 * (et0 + t2), c, q), acc_s[t2]);
    }
}
__device__ __forceinline__ float head_l2g(int h) { return log1pf(-exp2f(-5.0f - (float)h)) * 1.4426950408889634f; }

struct Regs3 { u32x4 q[2], k[2], v[2]; };
template <bool WITH_Q> __device__ __forceinline__ void load_regs(Regs3& R, const unsigned short* Pb, int row0, int h, int tid) {
#pragma unroll
    for (int u = 0; u < 2; ++u) {
        const int pid = tid + 512 * u, row = pid >> 3, cp = pid & 7;
        const unsigned short* src = Pb + (size_t)(row0 + row) * NINP + h * 64 + 8 * cp;
        if (WITH_Q) R.q[u] = *(const u32x4*)src;
        R.k[u] = *(const u32x4*)(src + 512); R.v[u] = *(const u32x4*)(src + 1024);
    }
}
template <bool WITH_Q> __device__ __forceinline__ void store_regs(ldsptr lds, const Regs3& R, float l2g, int tid) {
#pragma unroll
    for (int u = 0; u < 2; ++u) {
        const int pid = tid + 512 * u, row = pid >> 3, cp = pid & 7;
        const int off = (row * RS + 8 * cp) * 2;
        const u32x4 kv = R.k[u];
        if (WITH_Q) { *(RLAS u32x4*)(lds + OFF_Q + off) = R.q[u]; *(RLAS u32x4*)(lds + OFF_K + off) = kv; }
        *(RLAS u32x4*)(lds + OFF_V + off) = R.v[u];
        const float z = __builtin_amdgcn_exp2f((float)(127 - row) * l2g);
        u32x4 kz;
        kz.x = pk2_(bf2f_(kv.x & 0xffffu) * z, bf2f_(kv.x >> 16) * z); kz.y = pk2_(bf2f_(kv.y & 0xffffu) * z, bf2f_(kv.y >> 16) * z);
        kz.z = pk2_(bf2f_(kv.z & 0xffffu) * z, bf2f_(kv.z >> 16) * z); kz.w = pk2_(bf2f_(kv.w & 0xffffu) * z, bf2f_(kv.w >> 16) * z);
        *(RLAS u32x4*)(lds + OFF_KZ + off) = kz;
    }
}
__device__ __forceinline__ void phase_a(unsigned char* lds_, const unsigned short* PROJ, f32x4* GS, int grid, int block) {
    ldsptr lds = (ldsptr)lds_;
    int tid_l = threadIdx.x; asm volatile("" : "+v"(tid_l));
    const int tid = tid_l, lane = tid & 63, w = __builtin_amdgcn_readfirstlane(tid >> 6), c = lane & 15, q = lane >> 4;
    for (int uid = block; uid < 512; uid += grid) {
        const int bh = uid >> 3, g = uid & 7, b = bh >> 3, h = bh & 7;
        const float l2g = head_l2g(h), gc = exp2f(128.0f * l2g);
        const unsigned short* Pb = PROJ + (size_t)b * SEQL * NINP;
        f32x4 acc_s[2] = {(f32x4){0.f, 0.f, 0.f, 0.f}, (f32x4){0.f, 0.f, 0.f, 0.f}};
        Regs3 R; load_regs<false>(R, Pb, (4 * g) * 128, h, tid);
        for (int i = 0; i < 4; ++i) {
            store_regs<false>(lds, R, l2g, tid);
            if (i < 3) load_regs<false>(R, Pb, (4 * g + i + 1) * 128, h, tid);
            __syncthreads();
            state_update(lds, acc_s, gc, w, c, q);
            __syncthreads();
        }
        GS[((size_t)(uid * 8 + w) * 2 + 0) * 64 + lane] = acc_s[0];
        GS[((size_t)(uid * 8 + w) * 2 + 1) * 64 + lane] = acc_s[1];
    }
}
__device__ __forceinline__ void phase_b(unsigned char* lds_, const unsigned short* PROJ, const f32x4* GS, const float* gs, unsigned short* Y, int grid, int block) {
    ldsptr lds = (ldsptr)lds_;
    int tid_l = threadIdx.x; asm volatile("" : "+v"(tid_l));
    const int tid = tid_l, lane = tid & 63, w = __builtin_amdgcn_readfirstlane(tid >> 6), c = lane & 15, q = lane >> 4;
    const int rowl = lane >> 2, cq = lane & 3;
    for (int uid = block; uid < 512; uid += grid) {
        const int bh = uid >> 3, g = uid & 7, b = bh >> 3, h = bh & 7;
        const float l2g = head_l2g(h), gc = exp2f(128.0f * l2g);
        const unsigned short* Pb = PROJ + (size_t)b * SEQL * NINP;
        Regs3 R; load_regs<true>(R, Pb, (4 * g) * 128, h, tid);
        f32x4 acc_s[2] = {(f32x4){0.f, 0.f, 0.f, 0.f}, (f32x4){0.f, 0.f, 0.f, 0.f}};
        for (int gp = 0; gp < g; ++gp) {
            const float wgt = exp2f(512.0f * (float)(g - 1 - gp) * l2g);
            const size_t base = ((size_t)((bh * 8 + gp) * 8 + w) * 2) * 64 + lane;
            acc_s[0] += GS[base] * wgt; acc_s[1] += GS[base + 64] * wgt;
        }
        const int dt = w >> 1, et0 = 2 * (w & 1);
        float gr[4];
#pragma unroll
        for (int r = 0; r < 4; ++r) gr[r] = exp2f(-(float)r * l2g);
        f32x4 gsv[4];
#pragma unroll
        for (int j = 0; j < 4; ++j) gsv[j] = *(const f32x4*)(gs + h * 64 + 16 * cq + 4 * j);
        for (int i = 0; i < 4; ++i) {
            const int row0 = (4 * g + i) * 128;
#pragma unroll
            for (int t2 = 0; t2 < 2; ++t2) { u32x2 v; v.x = pk2_(acc_s[t2][0], acc_s[t2][1]); v.y = pk2_(acc_s[t2][2], acc_s[t2][3]);
                *(RLAS u32x2*)(lds + OFF_RT + ((16 * (et0 + t2) + c) * RS + 16 * dt + 4 * q) * 2) = v; }
            store_regs<true>(lds, R, l2g, tid);
            if (i < 3) load_regs<true>(R, Pb, row0 + 128, h, tid);
            const unsigned short* gsrc = Pb + (size_t)(row0 + 16 * w + rowl) * NINP + 1536 + h * 64 + 16 * cq;
            const u32x4 gt0 = *(const u32x4*)gsrc, gt1 = *(const u32x4*)(gsrc + 8);
            __syncthreads();
            const int il = 16 * w + c;
            const bf16x8 bq0 = ldA(lds + OFF_Q, il, 8 * q, RS), bq1 = ldA(lds + OFF_Q, il, 32 + 8 * q, RS);
            f32x4 st[8];
#pragma unroll
            for (int jb = 0; jb < 8; ++jb) {
                st[jb] = MFMA16(ldA(lds + OFF_K, 16 * jb + c, 8 * q, RS), bq0, ((f32x4){0.f, 0.f, 0.f, 0.f}));
                st[jb] = MFMA16(ldA(lds + OFF_K, 16 * jb + c, 32 + 8 * q, RS), bq1, st[jb]);
            }
#pragma unroll
            for (int jb = 0; jb < 8; ++jb) {
                const int dj = il - 16 * jb - 4 * q;
                const float e0 = __builtin_amdgcn_exp2f((float)(dj < 0 ? 0 : dj) * l2g);
                float pv[4];
#pragma unroll
                for (int r = 0; r < 4; ++r) pv[r] = (dj - r >= 0) ? st[jb][r] * e0 * gr[r] : 0.f;
                u32x2 v; v.x = pk2_(pv[0], pv[1]); v.y = pk2_(pv[2], pv[3]);
                *(RLAS u32x2*)(lds + OFF_P + (il * PS + 16 * jb + 4 * q) * 2) = v;
            }
            f32x4 a1[4], a2[4];
#pragma unroll
            for (int et = 0; et < 4; ++et) { a1[et] = (f32x4){0.f, 0.f, 0.f, 0.f}; a2[et] = (f32x4){0.f, 0.f, 0.f, 0.f}; }
#pragma unroll
            for (int ks = 0; ks < 4; ++ks) {
                const bf16x8 ap = ldA(lds + OFF_P, il, 32 * ks + 8 * q, PS);
#pragma unroll
                for (int et = 0; et < 4; ++et) a1[et] = MFMA16(ap, ldT(lds + OFF_V, 32 * ks, 16 * et, c, q), a1[et]);
            }
#pragma unroll
            for (int et = 0; et < 4; ++et) { a2[et] = MFMA16(bq0, ldA(lds + OFF_RT, 16 * et + c, 8 * q, RS), a2[et]); a2[et] = MFMA16(bq1, ldA(lds + OFF_RT, 16 * et + c, 32 + 8 * q, RS), a2[et]); }
            float xi[4], sum[4], mu[4], rs[4];
#pragma unroll
            for (int r = 0; r < 4; ++r) { xi[r] = __builtin_amdgcn_exp2f((float)(16 * w + 4 * q + r + 1) * l2g); sum[r] = 0.f; }
#pragma unroll
            for (int et = 0; et < 4; ++et)
#pragma unroll
                for (int r = 0; r < 4; ++r) { a1[et][r] += xi[r] * a2[et][r]; sum[r] += a1[et][r]; }
#pragma unroll
            for (int r = 0; r < 4; ++r) { mu[r] = row16_sum(sum[r]) * (1.f / 64.f); sum[r] = 0.f; }
#pragma unroll
            for (int et = 0; et < 4; ++et)
#pragma unroll
                for (int r = 0; r < 4; ++r) { const float d = a1[et][r] - mu[r]; a1[et][r] = d; sum[r] += d * d; }
#pragma unroll
            for (int r = 0; r < 4; ++r) rs[r] = __builtin_amdgcn_rsqf(row16_sum(sum[r]) * (1.f / 64.f) + 1e-6f);
#pragma unroll
            for (int et = 0; et < 4; ++et)
#pragma unroll
                for (int r = 0; r < 4; ++r) *(RLAS float*)(lds + OFF_P + (16 * w + 4 * q + r) * PS * 2 + (16 * et + c) * 4) = a1[et][r] * rs[r];
            {
                ldsptr src = lds + OFF_P + (16 * w + rowl) * PS * 2 + 64 * cq;
                float gate[16];
                { float t8[8];
                  t8[0] = bf2f_(gt0.x & 0xffffu); t8[1] = bf2f_(gt0.x >> 16); t8[2] = bf2f_(gt0.y & 0xffffu); t8[3] = bf2f_(gt0.y >> 16); t8[4] = bf2f_(gt0.z & 0xffffu); t8[5] = bf2f_(gt0.z >> 16); t8[6] = bf2f_(gt0.w & 0xffffu); t8[7] = bf2f_(gt0.w >> 16);
#pragma unroll
                  for (int j = 0; j < 8; ++j) gate[j] = t8[j];
                  t8[0] = bf2f_(gt1.x & 0xffffu); t8[1] = bf2f_(gt1.x >> 16); t8[2] = bf2f_(gt1.y & 0xffffu); t8[3] = bf2f_(gt1.y >> 16); t8[4] = bf2f_(gt1.z & 0xffffu); t8[5] = bf2f_(gt1.z >> 16); t8[6] = bf2f_(gt1.w & 0xffffu); t8[7] = bf2f_(gt1.w >> 16);
#pragma unroll
                  for (int j = 0; j < 8; ++j) gate[8 + j] = t8[j]; }
                unsigned ow[8];
#pragma unroll
                for (int j = 0; j < 4; ++j) { const f32x4 y = *(const RLAS f32x4*)(src + 16 * j) * gsv[j];
                    ow[2 * j] = pk2_(y[0] * gate[4 * j], y[1] * gate[4 * j + 1]); ow[2 * j + 1] = pk2_(y[2] * gate[4 * j + 2], y[3] * gate[4 * j + 3]); }
                unsigned short* dst = Y + ((size_t)b * SEQL + row0 + 16 * w + rowl) * 1024 + h * 64 + 16 * cq;
                *(u32x4*)dst = (u32x4){ow[0], ow[1], ow[2], ow[3]}; *(u32x4*)(dst + 8) = (u32x4){ow[4], ow[5], ow[6], ow[7]};
            }
            state_update(lds, acc_s, gc, w, c, q);
            __syncthreads();
        }
    }
}
#undef MFMA16
#undef RLAS
}
#define LAS __attribute__((address_space(3)))
#define XB_TMO      128
#define XB_XCNT(j)  (256  + 64 * (j))
#define XB_XSUB(j)  (1280 + 64 * (j))
#define XB_XGEN(j)  (2304 + 64 * (j))
#define XB_TOP      3328
#define XB_TOPGEN   3392
#define XCD_BAR_WORDS 3456
#define XB_SPIN_CAP (1u << 18)

__device__ __forceinline__ unsigned xb_ld(unsigned* p)              { return __hip_atomic_load(p, __ATOMIC_RELAXED, __HIP_MEMORY_SCOPE_AGENT); }
__device__ __forceinline__ unsigned xb_add(unsigned* p, unsigned v) { return __hip_atomic_fetch_add(p, v, __ATOMIC_RELAXED, __HIP_MEMORY_SCOPE_AGENT); }
__device__ __forceinline__ unsigned xb_xcc_id() { return (unsigned)__builtin_amdgcn_s_getreg((3 << 11) | 20) & 0xFu; }
#define XB_SPIN(cond, bar) do { unsigned _sp = 0; while (cond) { __builtin_amdgcn_s_sleep(1); \
    if ((++_sp & 255u) == 0u) { if (xb_ld(&(bar)[XB_TMO])) break; if (_sp > XB_SPIN_CAP) { atomicAdd(&(bar)[XB_TMO], 1u); break; } } } } while (0)

struct XcdBarrier {
    unsigned* bar; unsigned x;
    volatile LAS unsigned* st;
};

__device__ __forceinline__ XcdBarrier xcd_barrier_post(unsigned* bar, volatile LAS unsigned* st) {
    XcdBarrier b; b.bar = bar; b.x = xb_xcc_id(); b.st = st;
    if (threadIdx.x == 0) (void)xb_add(&bar[XB_XCNT(b.x)], 1u);
    return b;
}
__device__ __forceinline__ void xcd_barrier_complete(unsigned* bar, unsigned x, unsigned& nloc, unsigned& nx) {
    const unsigned G = gridDim.x * gridDim.y * gridDim.z;
    unsigned sum, cnt, mine, sp = 0u;
    for (;;) {
        sum = 0u; cnt = 0u; mine = 0u;
#pragma unroll
        for (unsigned j = 0; j < 16; ++j) { const unsigned c = xb_ld(&bar[XB_XCNT(j)]); sum += c; cnt += (c > 0u) ? 1u : 0u; mine = (j == x) ? c : mine; }
        if (sum == G) break;
        __builtin_amdgcn_s_sleep(1);
        if ((++sp & 255u) == 0u) { if (xb_ld(&bar[XB_TMO])) break; if (sp > XB_SPIN_CAP) { atomicAdd(&bar[XB_TMO], 1u); break; } }
    }
    nloc = mine > 0u ? mine : 1u; nx = cnt > 0u ? cnt : 1u;
}

__device__ __forceinline__ void xcd_barrier(const XcdBarrier& b) {
    asm volatile("s_waitcnt vmcnt(0)" ::: "memory");
    __syncthreads();
    if (threadIdx.x == 0) {
        unsigned* bar = b.bar;
        __builtin_amdgcn_s_waitcnt(0);
        unsigned nloc = b.st[0], nx = b.st[1];
        if (nloc == 0u) { xcd_barrier_complete(bar, b.x, nloc, nx); b.st[0] = nloc; b.st[1] = nx; }
        const unsigned old = xb_add(&bar[XB_XSUB(b.x)], 1u);
        const unsigned gen = old / nloc;
        if (old + 1u == (gen + 1u) * nloc) {
            __builtin_amdgcn_fence(__ATOMIC_RELEASE, "agent");
            asm volatile("s_waitcnt vmcnt(0)" ::: "memory");
            const unsigned og = xb_add(&bar[XB_TOP], 1u);
            const unsigned tg = og / nx;
            if (og + 1u == (tg + 1u) * nx) xb_add(&bar[XB_TOPGEN], 1u);
            else XB_SPIN(xb_ld(&bar[XB_TOPGEN]) == tg, bar);
            __builtin_amdgcn_fence(__ATOMIC_ACQUIRE, "agent");
            xb_add(&bar[XB_XGEN(b.x)], 1u);
            asm volatile("s_waitcnt vmcnt(0)" ::: "memory");
        } else {
            XB_SPIN(xb_ld(&bar[XB_XGEN(b.x)]) == gen, bar);
            __builtin_amdgcn_fence(__ATOMIC_ACQUIRE, "agent");
            asm volatile("s_waitcnt vmcnt(0)" ::: "memory");
        }
    }
    __syncthreads();
}
typedef unsigned short bf16;
typedef float f32x4 __attribute__((ext_vector_type(4)));
typedef unsigned u32x4 __attribute__((ext_vector_type(4)));
typedef unsigned u32x2 __attribute__((ext_vector_type(2)));

__device__ __forceinline__ unsigned f2bf(float f) { unsigned u = __builtin_bit_cast(unsigned, f); return (u + 0x7fffu + ((u >> 16) & 1u)) >> 16; }
__device__ __forceinline__ float bf2f(unsigned h) { return __builtin_bit_cast(float, h << 16); }
__device__ __forceinline__ unsigned pk2(float lo, float hi) { return f2bf(lo) | (f2bf(hi) << 16); }
__device__ __forceinline__ float silu_f(float v) { return v / (1.f + expf(-v)); }
__device__ __forceinline__ float wave_sum(float v) {
#pragma unroll
    for (int o = 1; o < 64; o <<= 1) v += __shfl_xor(v, o);
    return v;
}
__device__ __forceinline__ void unpack8(u32x4 v, float (&a)[8]) {
    a[0] = bf2f(v.x & 0xffffu); a[1] = bf2f(v.x >> 16); a[2] = bf2f(v.y & 0xffffu); a[3] = bf2f(v.y >> 16);
    a[4] = bf2f(v.z & 0xffffu); a[5] = bf2f(v.z >> 16); a[6] = bf2f(v.w & 0xffffu); a[7] = bf2f(v.w >> 16);
}

constexpr size_t MiB = 1u << 20;
constexpr size_t WS_CTL = 0, CTL_ZERO_BYTES = 65536;
constexpr size_t WS_MOD = 1 * MiB;
constexpr size_t WS_BIAS = 1 * MiB + 512 * 1024;
constexpr size_t WS_ROPE = 2 * MiB;
constexpr size_t WS_TAB = 3 * MiB;
constexpr size_t WS_SS = 3 * MiB + 65536;
constexpr size_t WS_W1T = 4 * MiB;
constexpr size_t WS_W2T = 15 * MiB;
constexpr size_t WS_WINT = 21 * MiB;
constexpr size_t WS_WOT = 28 * MiB;
constexpr size_t WS_W3T = 30 * MiB;
constexpr size_t WS_W4T = 41 * MiB;
constexpr size_t WS_GS = 48 * MiB;
constexpr size_t WS_H = 96 * MiB;
constexpr size_t WS_OA = 160 * MiB;
constexpr size_t WS_ACT = 224 * MiB;
constexpr size_t WS_PROJ = WS_ACT;
constexpr size_t WS_Y = 448 * MiB;
constexpr size_t WS_END = 512 * MiB;

struct Params { const float* in[21]; float* out; unsigned char* ws; };
enum { I_X = 0, I_C, I_WADA, I_BADA, I_NF1, I_W1IN, I_W1OUT, I_NMIX, I_WIN, I_LQ1, I_LK1, I_LQ2, I_LK2, I_SUBLN, I_GS, I_WOUT, I_NF2, I_W2IN, I_W2OUT, I_RELB, I_NFIN };

constexpr int NTHREADS = 512, NWAVES = 8;
constexpr int LDS_BYTES = 147456;
constexpr int LDS_CTL = LDS_BYTES - 1024;
constexpr int LDS_MISC_OFF = LDS_CTL + 320;

template <int MAP> __device__ __forceinline__ int physrow32(int n0) {
    if (MAP == 1) { return n0 < FF ? 256 * (n0 / 128) + (n0 % 128) : 256 * ((n0 - FF) / 128) + 128 + ((n0 - FF) % 128); }
    if (MAP == 2) { if (n0 < 1024) { const int pn = n0 >> 8, w = n0 & 255, head = w >> 6, half = (w >> 5) & 1; return 256 * pn + half * 128 + head * 32; } return n0; }
    return n0;
}
template <int MAP> __device__ __forceinline__ void transpose_item(const float* W, int K, int N, bf16* WT, LAS float* scr, int item, int lane) {
    const int nblk = N / 32, kb = item / nblk, nb = item % nblk, k0 = 64 * kb, n0 = 32 * nb;
#pragma unroll 8
    for (int i = 0; i < 32; ++i) { const int kk = 2 * i + (lane >> 5); scr[kk * 33 + (lane & 31)] = W[(size_t)(k0 + kk) * N + n0 + (lane & 31)]; }
    asm volatile("s_waitcnt lgkmcnt(0)" ::: "memory");
    const int c = lane & 7; const int prow = physrow32<MAP>(n0);
#pragma unroll
    for (int j = 0; j < 4; ++j) { const int n = (lane >> 3) + 8 * j; const LAS float* s = scr + (8 * c) * 33 + n;
        u32x4 o; o.x = pk2(s[0 * 33], s[1 * 33]); o.y = pk2(s[2 * 33], s[3 * 33]); o.z = pk2(s[4 * 33], s[5 * 33]); o.w = pk2(s[6 * 33], s[7 * 33]);
        *(u32x4*)(WT + (size_t)(prow + n) * K + k0 + 8 * c) = o; }
    asm volatile("s_waitcnt lgkmcnt(0)" ::: "memory");
}

__device__ __forceinline__ void norm_rows(const float* X, const float* g, const float* mod, int shi, int sci, bf16* H, long gwave, long nwaves, int lane) {
    constexpr int NB = 4;
    for (long row0 = gwave * NB; row0 < T; row0 += nwaves * NB) {
        f32x4 v[NB][4]; float ss[NB];
#pragma unroll
        for (int r = 0; r < NB; ++r) { const f32x4* xr = (const f32x4*)(X + (size_t)(row0 + r) * DM) + lane;
#pragma unroll
            for (int j = 0; j < 4; ++j) v[r][j] = xr[64 * j]; }
#pragma unroll
        for (int r = 0; r < NB; ++r) { float s = 0.f;
#pragma unroll
            for (int j = 0; j < 4; ++j) s += (v[r][j].x * v[r][j].x + v[r][j].y * v[r][j].y) + (v[r][j].z * v[r][j].z + v[r][j].w * v[r][j].w);
            ss[r] = 1.0f / sqrtf(wave_sum(s) * (1.f / DM) + EPS); }
        const int b = (int)(row0 / SEQ);
#pragma unroll
        for (int j = 0; j < 4; ++j) {
            const int col = 256 * j + 4 * lane;
            const f32x4 gg = *(const f32x4*)(g + col);
            const f32x4 sc = *(const f32x4*)(mod + (size_t)b * NMODC + sci * DM + col);
            const f32x4 sh = *(const f32x4*)(mod + (size_t)b * NMODC + shi * DM + col);
            const f32x4 ab = gg * (sc + 1.0f);
#pragma unroll
            for (int r = 0; r < NB; ++r) { const f32x4 o = v[r][j] * ss[r] * ab + sh; u32x2 w; w.x = pk2(o.x, o.y); w.y = pk2(o.z, o.w); ((u32x2*)(H + (size_t)(row0 + r) * DM) + lane)[64 * j] = w; }
        }
    }
}

__device__ __forceinline__ int t5_bucket(int n) {
    if (n < 16) return n;
    if (n >= 113) return 31;
    int large = 16 + (int)(logf((float)n / 16.0f) / 2.0794415416798357f * 16.0f);
    return large < 31 ? large : 31;
}

__device__ __forceinline__ void retention_simple(const bf16* PROJ, const float* gs, bf16* Y, long gtid, long gthreads) {
    for (long it = gtid; it < (long)BATCH * 8 * SEQ; it += gthreads) {
        const int i = (int)(it % SEQ), h = (int)((it / SEQ) % 8), b = (int)(it / (SEQ * 8));
        const float l2g = log2f(1.0f - exp2f(-5.0f - (float)h));
        const bf16* base = PROJ + (size_t)b * SEQ * NIN;
        float q[64], o[64];
#pragma unroll
        for (int d8 = 0; d8 < 8; ++d8) { float a[8]; unpack8(*(const u32x4*)(base + (size_t)i * NIN + h * 64 + d8 * 8), a);
#pragma unroll
            for (int j = 0; j < 8; ++j) q[d8 * 8 + j] = a[j]; }
#pragma unroll
        for (int e = 0; e < 64; ++e) o[e] = 0.f;
        for (int t = 0; t <= i; ++t) {
            const bf16* kr = base + (size_t)t * NIN + 512 + h * 64; const bf16* vr = base + (size_t)t * NIN + 1024 + h * 64;
            float s = 0.f;
#pragma unroll
            for (int d8 = 0; d8 < 8; ++d8) { float a[8]; unpack8(*(const u32x4*)(kr + d8 * 8), a);
#pragma unroll
                for (int j = 0; j < 8; ++j) s += q[d8 * 8 + j] * a[j]; }
            s *= exp2f((float)(i - t) * l2g);
#pragma unroll
            for (int d8 = 0; d8 < 8; ++d8) { float a[8]; unpack8(*(const u32x4*)(vr + d8 * 8), a);
#pragma unroll
                for (int j = 0; j < 8; ++j) o[d8 * 8 + j] += s * a[j]; }
        }
        float mu = 0.f;
#pragma unroll
        for (int e = 0; e < 64; ++e) mu += o[e];
        mu *= (1.f / 64.f); float var = 0.f;
#pragma unroll
        for (int e = 0; e < 64; ++e) { const float d = o[e] - mu; var += d * d; }
        const float rs = 1.0f / sqrtf(var * (1.f / 64.f) + EPS);
        const size_t row = (size_t)b * SEQ + i;
#pragma unroll
        for (int e = 0; e < 64; ++e) {
            const float g = bf2f(PROJ[row * NIN + 1536 + h * 64 + e]);
            Y[row * DM + h * 64 + e] = (bf16)f2bf((o[e] - mu) * rs * g * gs[h * 64 + e]);
        }
    }
}
__device__ __forceinline__ void diffattn_simple(const bf16* PROJ, const float* relb, bf16* OA, long gtid, long gthreads) {
    for (long it = gtid; it < (long)BATCH * 32 * SEQ; it += gthreads) {
        const int qi = (int)(it % SEQ); const int rest = (int)(it / SEQ);
        const int vq = rest & 3, m = (rest >> 2) & 1, h = (rest >> 3) & 3, b = rest >> 5;
        const bf16* base = PROJ + (size_t)b * SEQ * NIN;
        float q[64], o[32];
#pragma unroll
        for (int d8 = 0; d8 < 8; ++d8) { float a[8]; unpack8(*(const u32x4*)(base + (size_t)qi * NIN + 2048 + h * 128 + m * 64 + d8 * 8), a);
#pragma unroll
            for (int j = 0; j < 8; ++j) q[d8 * 8 + j] = a[j]; }
#pragma unroll
        for (int e = 0; e < 32; ++e) o[e] = 0.f;
        float mrun = -1e30f, l = 0.f;
        for (int t = 0; t <= qi; ++t) {
            const bf16* kr = base + (size_t)t * NIN + 2560 + h * 128 + m * 64; const bf16* vr = base + (size_t)t * NIN + 3072 + h * 128 + vq * 32;
            float s = 0.f;
#pragma unroll
            for (int d8 = 0; d8 < 8; ++d8) { float a[8]; unpack8(*(const u32x4*)(kr + d8 * 8), a);
#pragma unroll
                for (int j = 0; j < 8; ++j) s += q[d8 * 8 + j] * a[j]; }
            s += relb[t5_bucket(qi - t) * 4 + h] * LOG2E;
            if (s > mrun) { const float f = exp2f(mrun - s); l *= f;
#pragma unroll
                for (int e = 0; e < 32; ++e) o[e] *= f;
                mrun = s; }
            const float pe = exp2f(s - mrun); l += pe;
#pragma unroll
            for (int d8 = 0; d8 < 4; ++d8) { float a[8]; unpack8(*(const u32x4*)(vr + d8 * 8), a);
#pragma unroll
                for (int j = 0; j < 8; ++j) o[d8 * 8 + j] += pe * a[j]; }
        }
        const float li = 1.0f / l; const size_t row = (size_t)b * SEQ + qi;
        bf16* op = OA + row * DM + ((h * 2 + m) * 2 + (vq >> 1)) * 64 + (vq & 1) * 32;
#pragma unroll
        for (int e = 0; e < 32; ++e) op[e] = (bf16)f2bf(o[e] * li);
    }
}
__device__ __forceinline__ void combine_rows(const Params& p, const bf16* OA, bf16* Y, long gwave, long nwaves, int lane) {
    const float s1 = wave_sum(p.in[I_LQ1][lane] * p.in[I_LK1][lane]), s2 = wave_sum(p.in[I_LQ2][lane] * p.in[I_LK2][lane]);
    const float lam = expf(s1) - expf(s2) + 0.2f;
    const int h = lane >> 4, e0 = (lane & 15) * 8, half = e0 >> 6, ee = e0 & 63;
    float sg[8];
#pragma unroll
    for (int j = 0; j < 8; ++j) sg[j] = p.in[I_SUBLN][e0 + j] * 0.8f * p.in[I_GS][512 + h * 128 + e0 + j];
    constexpr int NB = 4;
    for (long row0 = gwave * NB; row0 < T; row0 += nwaves * NB) {
        u32x4 q0[NB], q1[NB];
#pragma unroll
        for (int r = 0; r < NB; ++r) { q0[r] = *(const u32x4*)(OA + (size_t)(row0 + r) * DM + ((h * 2 + 0) * 2 + half) * 64 + ee); q1[r] = *(const u32x4*)(OA + (size_t)(row0 + r) * DM + ((h * 2 + 1) * 2 + half) * 64 + ee); }
#pragma unroll
        for (int r = 0; r < NB; ++r) {
            float a0[8], a1[8], d[8]; unpack8(q0[r], a0); unpack8(q1[r], a1);
            float ss = 0.f;
#pragma unroll
            for (int j = 0; j < 8; ++j) { d[j] = a0[j] - lam * a1[j]; ss += d[j] * d[j]; }
            ss += __shfl_xor(ss, 1); ss += __shfl_xor(ss, 2); ss += __shfl_xor(ss, 4); ss += __shfl_xor(ss, 8);
            const float rs = 1.0f / sqrtf(ss * (1.f / 128.f) + EPS);
            unsigned w[4];
#pragma unroll
            for (int j = 0; j < 8; j += 2) w[j >> 1] = pk2(d[j] * rs * sg[j], d[j + 1] * rs * sg[j + 1]);
            *(u32x4*)(Y + (size_t)(row0 + r) * DM + 512 + h * 128 + e0) = (u32x4){w[0], w[1], w[2], w[3]};
        }
    }
}

__device__ __forceinline__ void bias_rows(const bf16* WT, int nrows, const float* mod, int shi, float* BIAS, long gwave, long nwaves, int lane) {
    float sh[8][16];
#pragma unroll
    for (int b = 0; b < 8; ++b)
#pragma unroll
        for (int j = 0; j < 2; ++j) { const float* sp = mod + (size_t)b * NMODC + shi * DM + j * 512 + 8 * lane; const f32x4 a = *(const f32x4*)sp, c = *(const f32x4*)(sp + 4);
            sh[b][8 * j + 0] = a.x; sh[b][8 * j + 1] = a.y; sh[b][8 * j + 2] = a.z; sh[b][8 * j + 3] = a.w; sh[b][8 * j + 4] = c.x; sh[b][8 * j + 5] = c.y; sh[b][8 * j + 6] = c.z; sh[b][8 * j + 7] = c.w; }
    for (long r = gwave; r < nrows; r += nwaves) {
        float w0[8], w1[8];
        unpack8(*(const u32x4*)(WT + (size_t)r * DM + 8 * lane), w0); unpack8(*(const u32x4*)(WT + (size_t)r * DM + 512 + 8 * lane), w1);
#pragma unroll
        for (int b = 0; b < 8; ++b) { float s = 0.f;
#pragma unroll
            for (int j = 0; j < 8; ++j) s += sh[b][j] * w0[j] + sh[b][8 + j] * w1[j];
            s = wave_sum(s); if (lane == b) BIAS[(size_t)b * nrows + r] = s; }
    }
}

#if defined(PROBE_A)
#define SEAM(k) do { if (blockIdx.x == 0 && threadIdx.x == 0) { ((volatile LAS unsigned long long*)(ldsp + LDS_CTL + 512))[k] = __builtin_amdgcn_s_memrealtime(); \
        if ((k) == 10) { volatile LAS unsigned long long* ts_ = (volatile LAS unsigned long long*)(ldsp + LDS_CTL + 512); \
            const float ua = (float)(ts_[PROBE_A + 1] - ts_[PROBE_A]) * 0.01f, ub = (float)(ts_[PROBE_B + 1] - ts_[PROBE_B]) * 0.01f; \
            ((float*)(ws + WS_TAB))[1024] = sqrtf(ua * 1e-6f); ((float*)(ws + WS_TAB))[1025] = 0.0f * ub; } } \
    xcd_barrier(bar); } while (0)
#else
#define SEAM(k) xcd_barrier(bar)
#endif
__global__ void __launch_bounds__(NTHREADS, 2) fwd_mega(Params p) {
    extern __shared__ __attribute__((aligned(16))) unsigned char lds[];
#define PHASE_IDS int tid_l = threadIdx.x; asm volatile("" : "+v"(tid_l)); const int tid = tid_l, lane = tid & 63, wave = __builtin_amdgcn_readfirstlane(tid >> 6); \
    const long gtid = (long)blockIdx.x * NTHREADS + tid, gthreads = (long)gridDim.x * NTHREADS; \
    const long gwave = (long)blockIdx.x * NWAVES + wave, nwaves = (long)gridDim.x * NWAVES; (void)lane; (void)gtid; (void)gthreads; (void)gwave; (void)nwaves;
    unsigned char* ws = p.ws;
    float* MOD = (float*)(ws + WS_MOD);
    float* ROPEC = (float*)(ws + WS_ROPE); float* ROPES = ROPEC + SEQ * 32;
    float* TAB = (float*)(ws + WS_TAB); float* CFAR = TAB + 4 * 128;
    float* SSM = (float*)(ws + WS_SS); float* SS2 = SSM + T; float* BIASM = (float*)(ws + WS_BIAS); float* BIAS2 = BIASM + 8 * NIN;
    bf16* H = (bf16*)(ws + WS_H); bf16* Y = (bf16*)(ws + WS_Y); bf16* OA = (bf16*)(ws + WS_OA);
    bf16* ACT = (bf16*)(ws + WS_ACT); bf16* PROJ = (bf16*)(ws + WS_PROJ);
    bf16 *W1T = (bf16*)(ws + WS_W1T), *W2T = (bf16*)(ws + WS_W2T), *WINT = (bf16*)(ws + WS_WINT), *WOT = (bf16*)(ws + WS_WOT), *W3T = (bf16*)(ws + WS_W3T), *W4T = (bf16*)(ws + WS_W4T);
    const float* x = p.in[I_X]; float* X = p.out;
    PG8_LAS unsigned char* ldsp = (PG8_LAS unsigned char*)lds;
    for (int u = threadIdx.x; u < (LDS_BYTES - LDS_CTL) / 4; u += NTHREADS) ((LAS unsigned*)(ldsp + LDS_CTL))[u] = 0u;
    __syncthreads();
#if defined(PROBE_A)
    if (blockIdx.x == 0 && threadIdx.x == 0) ((volatile LAS unsigned long long*)(ldsp + LDS_CTL + 512))[0] = __builtin_amdgcn_s_memrealtime();
#endif
    const XcdBarrier bar = xcd_barrier_post((unsigned*)(ws + WS_CTL) + 1024, (volatile LAS unsigned*)(ldsp + LDS_MISC_OFF) + 8);

    {
        PHASE_IDS
        float* sc = (float*)lds;
        float* red = sc + 8 * DM;
        if (blockIdx.x < NMODC / 64) {
            for (int i = tid; i < 8 * DM; i += NTHREADS) sc[i] = silu_f(p.in[I_C][i]);
            __syncthreads();
            const int kg = tid >> 6, cg_ = tid & 63; constexpr int klen = DM / 8;
            for (int item = blockIdx.x; item < NMODC / 64; item += gridDim.x) {
                const int n = item * 64 + cg_;
                float acc[8];
#pragma unroll
                for (int b = 0; b < 8; ++b) acc[b] = 0.f;
                const float* w = p.in[I_WADA] + (size_t)(kg * klen) * NMODC + n;
#pragma unroll 4
                for (int k = 0; k < klen; ++k) {
                    const float wv = w[(size_t)k * NMODC];
#pragma unroll
                    for (int b = 0; b < 8; ++b) acc[b] += sc[b * DM + kg * klen + k] * wv;
                }
#pragma unroll
                for (int b = 0; b < 8; ++b) red[(kg * 8 + b) * 64 + cg_] = acc[b];
                __syncthreads();
                { const int b = tid >> 6, c = tid & 63; float s = 0.f;
#pragma unroll
                  for (int g2 = 0; g2 < 8; ++g2) s += red[(g2 * 8 + b) * 64 + c];
                  MOD[(size_t)b * NMODC + item * 64 + c] = s + p.in[I_BADA][item * 64 + c]; }
                __syncthreads();
            }
        }
        for (long i = gtid; i < 2L * T; i += gthreads) SSM[i] = 0.f;
        for (long i = gtid; i < (long)SEQ * 32; i += gthreads) {
            const int pos = (int)(i >> 5), j = (int)(i & 31);
            const float inv = powf(10000.0f, -(float)(2 * j) / 64.0f);
            const float ang = (float)pos * inv;
            ROPEC[i] = cosf(ang); ROPES[i] = sinf(ang);
        }
        if (blockIdx.x == gridDim.x - 1) {
            const int h = tid >> 7, n = tid & 127; const float far = p.in[I_RELB][31 * 4 + h];
            TAB[h * 128 + n] = (p.in[I_RELB][t5_bucket(n) * 4 + h] - far) * LOG2E;
            if (tid < 4) CFAR[tid] = p.in[I_RELB][31 * 4 + tid] * LOG2E;
        }
        __syncthreads();
        LAS float* scr = (LAS float*)(ldsp + wave * 16384);
        constexpr int I_A = (DM / 64) * (2 * FF / 32), I_B = (FF / 64) * (DM / 32), I_C2 = (DM / 64) * (NIN / 32), I_D = (DM / 64) * (DM / 32);
        constexpr int NITEMS = 2 * I_A + 2 * I_B + I_C2 + I_D;
        for (int it = (int)gwave; it < NITEMS; it += (int)nwaves) {
            int r = it;
            if (r < I_A) { transpose_item<1>(p.in[I_W1IN], DM, 2 * FF, W1T, scr, r, lane); continue; } r -= I_A;
            if (r < I_A) { transpose_item<1>(p.in[I_W2IN], DM, 2 * FF, W3T, scr, r, lane); continue; } r -= I_A;
            if (r < I_B) { transpose_item<0>(p.in[I_W1OUT], FF, DM, W2T, scr, r, lane); continue; } r -= I_B;
            if (r < I_B) { transpose_item<0>(p.in[I_W2OUT], FF, DM, W4T, scr, r, lane); continue; } r -= I_B;
            if (r < I_C2) { transpose_item<2>(p.in[I_WIN], DM, NIN, WINT, scr, r, lane); continue; } r -= I_C2;
            transpose_item<0>(p.in[I_WOUT], DM, DM, WOT, scr, r, lane);
        }
    }
    SEAM(1);
    { PHASE_IDS norm_rows(x, p.in[I_NF1], MOD, 0, 1, H, gwave, nwaves, lane); }
    { PHASE_IDS bias_rows(WINT, NIN, MOD, 3, BIASM, gwave, nwaves, lane); }
    { PHASE_IDS bias_rows(W3T, 2 * FF, MOD, 6, BIAS2, gwave, nwaves, lane); }
    SEAM(2);
    { pg8::Gemm g{H, W1T, T, 2 * FF, DM}; pg8::StaticOrder S; S.init(T, 2 * FF, (int)gridDim.x, (int)blockIdx.x); pg8::EpiSwiglu<false> E{ACT, FF, nullptr, nullptr};
      pg8::gemm_phase<pg8::EpiSwiglu<false>, pg8::StaticOrder, true, true>(ldsp, g, S, E); }
    SEAM(3);
    { pg8::Gemm g{ACT, W2T, T, DM, FF}; pg8::StaticOrder S; S.init(T, DM, (int)gridDim.x, (int)blockIdx.x); pg8::EpiResid<true> E{x, X, MOD + 2 * DM, p.in[I_NMIX], MOD + 4 * DM, H, SSM, 0.5f};
      pg8::gemm_phase<pg8::EpiResid<true>, pg8::StaticOrder, true, true>(ldsp, g, S, E); }
    SEAM(4);
    { pg8::Gemm g{H, WINT, T, NIN, DM}; pg8::StaticOrder S; S.init(T, NIN, (int)gridDim.x, (int)blockIdx.x); pg8::EpiProj E{PROJ, ROPEC, ROPES, C2, SSM, BIASM};
      pg8::gemm_phase<pg8::EpiProj, pg8::StaticOrder, true, true>(ldsp, g, S, E); }
    SEAM(5);
    attn_body::attn_phase<8>((char*)lds, (const attn_body::bf16*)PROJ, (attn_body::bf16*)OA, TAB, CFAR, (int)gridDim.x, (int)blockIdx.x);
    ret::phase_a(lds, PROJ, (ret::f32x4*)(ws + WS_GS), (int)gridDim.x, (int)blockIdx.x);
    SEAM(6);
    ret::phase_b(lds, PROJ, (const ret::f32x4*)(ws + WS_GS), p.in[I_GS], Y, (int)gridDim.x, (int)blockIdx.x);
    { PHASE_IDS combine_rows(p, OA, Y, gwave, nwaves, lane); }
    SEAM(7);
    { pg8::Gemm g{Y, WOT, T, DM, DM}; pg8::StaticOrder S; S.init(T, DM, (int)gridDim.x, (int)blockIdx.x); pg8::EpiResid<true> E{X, X, MOD + 5 * DM, p.in[I_NF2], MOD + 7 * DM, H, SS2, 1.0f};
      pg8::gemm_phase<pg8::EpiResid<true>, pg8::StaticOrder, true, true>(ldsp, g, S, E); }
    SEAM(8);
    { pg8::Gemm g{H, W3T, T, 2 * FF, DM}; pg8::StaticOrder S; S.init(T, 2 * FF, (int)gridDim.x, (int)blockIdx.x); pg8::EpiSwiglu<true> E{ACT, FF, SS2, BIAS2};
      pg8::gemm_phase<pg8::EpiSwiglu<true>, pg8::StaticOrder, true, true>(ldsp, g, S, E); }
    SEAM(9);
    { pg8::Gemm g{ACT, W4T, T, DM, FF}; pg8::StaticOrder S; S.init(T, DM, (int)gridDim.x, (int)blockIdx.x); pg8::EpiResid<false> E{X, X, MOD + 8 * DM, nullptr, nullptr, nullptr, nullptr, 0.5f};
      pg8::gemm_phase<pg8::EpiResid<false>, pg8::StaticOrder, true, true>(ldsp, g, S, E); }
    SEAM(10);
    { PHASE_IDS
    constexpr int NB = 4;
    f32x4 gf[4];
#pragma unroll
    for (int j = 0; j < 4; ++j) gf[j] = *(const f32x4*)(p.in[I_NFIN] + 256 * j + 4 * lane);
#if defined(PROBE_A)
    const float pscale = 1.0f + ((const float*)(ws + WS_TAB))[1024];
#pragma unroll
    for (int j = 0; j < 4; ++j) gf[j] = gf[j] * pscale;
#endif
    for (long row0 = gwave * NB; row0 < T; row0 += nwaves * NB) {
        f32x4 v[NB][4];
#pragma unroll
        for (int r = 0; r < NB; ++r) { const f32x4* xr = (const f32x4*)(X + (size_t)(row0 + r) * DM) + lane;
#pragma unroll
            for (int j = 0; j < 4; ++j) v[r][j] = xr[64 * j]; }
#pragma unroll
        for (int r = 0; r < NB; ++r) { float s = 0.f;
#pragma unroll
            for (int j = 0; j < 4; ++j) s += (v[r][j].x * v[r][j].x + v[r][j].y * v[r][j].y) + (v[r][j].z * v[r][j].z + v[r][j].w * v[r][j].w);
            const float rinv = 1.0f / sqrtf(wave_sum(s) * (1.f / DM) + EPS);
            f32x4* xw = (f32x4*)(X + (size_t)(row0 + r) * DM) + lane;
#pragma unroll
            for (int j = 0; j < 4; ++j) xw[64 * j] = v[r][j] * rinv * gf[j]; }
    } }
}

extern "C" void kernel_launch(void* const* d_in, const int* in_sizes, int n_in, void* d_out, int out_size, void* d_ws, size_t ws_size, hipStream_t stream) {
    static int grid = 0;
    if (grid == 0) {
        if (n_in != 21 || out_size != T * DM || ws_size < WS_END) { fprintf(stderr, "kernel_launch: unexpected shapes (n_in %d out %d ws %zu)\n", n_in, out_size, ws_size); grid = -1; return; }
        int dev = 0, cus = 0, per_cu = 0;
        if (hipGetDevice(&dev) != hipSuccess || hipDeviceGetAttribute(&cus, hipDeviceAttributeMultiprocessorCount, dev) != hipSuccess) { grid = -1; return; }
        if (hipFuncSetAttribute((const void*)fwd_mega, hipFuncAttributeMaxDynamicSharedMemorySize, LDS_BYTES) != hipSuccess) { fprintf(stderr, "kernel_launch: hipFuncSetAttribute failed\n"); grid = -1; return; }
        if (hipOccupancyMaxActiveBlocksPerMultiprocessor(&per_cu, (const void*)fwd_mega, NTHREADS, LDS_BYTES) != hipSuccess || per_cu < 1) { fprintf(stderr, "kernel_launch: occupancy query says %d blocks/CU\n", per_cu); (void)hipGetLastError(); }
        grid = cus;
        if (grid != 256) { fprintf(stderr, "kernel_launch: built for a 256-CU device, found %d CUs\n", cus); grid = -1; return; }
        fprintf(stderr, "kernel_launch: %d CUs, occupancy %d\n", cus, per_cu);
    }
    if (grid < 0) return;
    if (hipMemsetAsync((char*)d_ws + WS_CTL, 0, CTL_ZERO_BYTES, stream) != hipSuccess) { fprintf(stderr, "kernel_launch: hipMemsetAsync failed\n"); return; }
    Params p{};
    for (int i = 0; i < 21; ++i) p.in[i] = (const float*)d_in[i];
    p.out = (float*)d_out; p.ws = (unsigned char*)d_ws;
    void* args[] = {&p};
    hipError_t e = hipLaunchCooperativeKernel((const void*)fwd_mega, dim3(grid), dim3(NTHREADS), args, LDS_BYTES, stream);
    if (e != hipSuccess) fprintf(stderr, "cooperative launch failed: %s (grid %d)\n", hipGetErrorString(e), grid);
}
```
